# Optimizing an MI355X kernel written in HIP

```python
import jax, jax.numpy as jnp
from jax import lax
import numpy as np

D_MODEL = 1024
BATCH = 8
SEQ = 2048
DEPTH = 4

CHUNK = 64
QBLOCK = 128
ROPE_THETA = 10000.0
EPS = 1e-6
N_MIXERS = 3
N_A = (DEPTH + 2) // 3
N_B = (DEPTH + 1) // 3
N_C = DEPTH // 3

A_WIDTH = D_MODEL
CONV_WIDTH = 3

B_HEADS = 16
B_HEAD_DIM = 64
B_WIDTH = B_HEADS * B_HEAD_DIM
IDX_HEADS = 8
IDX_DIM = 64
IDX_ROPE_DIM = 32
TOPK_MAX = 256
B_IN_COLS = 4 * B_WIDTH + IDX_HEADS * IDX_DIM + IDX_DIM + IDX_HEADS

C_HEADS = 16
C_Q_LORA = 384
C_KV_LORA = 256
C_NOPE = 64
C_ROPE = 32
C_V = 64
C_QK = C_NOPE + C_ROPE
C_WIDTH = C_HEADS * C_V
C_IN_COLS = C_Q_LORA + C_KV_LORA + C_ROPE + C_WIDTH

kernel_name = "hybrid_conv_dsa_mla_stream_encoder"


def rmsnorm(x, g):
    xf = x.astype(jnp.float32)
    y = xf * lax.rsqrt(jnp.mean(xf * xf, axis=-1, keepdims=True) + EPS)
    return (y * g.astype(jnp.float32)).astype(x.dtype)


def rope(x, pos):
    d = x.shape[-1]
    half = d // 2
    inv = ROPE_THETA ** (-jnp.arange(half, dtype=jnp.float32) / half)
    ang = pos.astype(jnp.float32)[..., None] * inv
    cos = jnp.cos(ang)[:, :, None, :]
    sin = jnp.sin(ang)[:, :, None, :]
    xf = x.astype(jnp.float32)
    x1, x2 = xf[..., :half], xf[..., half:]
    out = jnp.concatenate([x1 * cos - x2 * sin, x2 * cos + x1 * sin], axis=-1)
    return out.astype(x.dtype)


def chunk_visible(q_pos, k_pos):
    return (k_pos // CHUNK)[None, :] <= (q_pos // CHUNK)[:, None]


def short_conv_mixer(xn, w_in, conv_w, conv_b, w_out):
    bg, cg, hv, z = jnp.split(xn @ w_in, 4, axis=-1)
    u = cg * hv
    y = lax.conv_general_dilated(
        u, conv_w[:, None, :].astype(u.dtype), window_strides=(1,),
        padding=[(CONV_WIDTH - 1, 0)], dimension_numbers=("NWC", "WIO", "NWC"),
        feature_group_count=A_WIDTH) + conv_b
    return (bg * y * jax.nn.silu(z)) @ w_out


def dsa_mixer(xn, positions, w_in, q_norm, k_norm, w_out):
    bsz, seq, _ = xn.shape
    cuts = np.cumsum([B_WIDTH, B_WIDTH, B_WIDTH, B_WIDTH, IDX_HEADS * IDX_DIM, IDX_DIM]).tolist()
    q, k, v, z, qi, ki, wi = jnp.split(xn @ w_in, cuts, axis=-1)
    q = rope(rmsnorm(q.reshape(bsz, seq, B_HEADS, B_HEAD_DIM), q_norm), positions)
    k = rope(rmsnorm(k.reshape(bsz, seq, B_HEADS, B_HEAD_DIM), k_norm), positions)
    v = v.reshape(bsz, seq, B_HEADS, B_HEAD_DIM)
    qi = qi.reshape(bsz, seq, IDX_HEADS, IDX_DIM)
    qi = jnp.concatenate([rope(qi[..., :IDX_ROPE_DIM], positions), qi[..., IDX_ROPE_DIM:]], axis=-1)
    ki = ki[:, :, None, :]
    ki = jnp.concatenate([rope(ki[..., :IDX_ROPE_DIM], positions), ki[..., IDX_ROPE_DIM:]], axis=-1)[:, :, 0, :]
    wi = wi * (IDX_HEADS ** -0.5 * IDX_DIM ** -0.5)

    topk = min(TOPK_MAX, seq // 4)
    nb = seq // QBLOCK
    scale = B_HEAD_DIM ** -0.5

    def blocks(t):
        return t.reshape((bsz * nb, QBLOCK) + t.shape[2:])

    bidx = jnp.repeat(jnp.arange(bsz, dtype=jnp.int32), nb)
    qstart = jnp.tile(jnp.arange(nb, dtype=jnp.int32) * QBLOCK, bsz)
    k_pos = jnp.arange(seq, dtype=jnp.int32)

    def attend(args):
        q_b, qi_b, w_b, b, q0 = args
        k_b, v_b, ki_b = k[b], v[b], ki[b]
        rel = jax.nn.relu(jnp.einsum("qhd,sd->qhs", qi_b, ki_b).astype(jnp.float32))
        score = jnp.einsum("qh,qhs->qs", w_b.astype(jnp.float32), rel)
        q_pos = q0 + jnp.arange(QBLOCK, dtype=jnp.int32)
        score = jnp.where(chunk_visible(q_pos, k_pos), score, -jnp.inf)
        top_val, top_idx = lax.top_k(score, topk)
        valid = jnp.isfinite(top_val)
        k_sel = k_b[top_idx]
        v_sel = v_b[top_idx]
        logits = jnp.einsum("qhd,qkhd->qhk", q_b, k_sel).astype(jnp.float32) * scale
        logits = jnp.where(valid[:, None, :], logits, -jnp.inf)
        p = jax.nn.softmax(logits, axis=-1).astype(v_sel.dtype)
        return jnp.einsum("qhk,qkhd->qhd", p, v_sel)

    o = lax.map(attend, (blocks(q), blocks(qi), blocks(wi), bidx, qstart))
    o = o.reshape(bsz, seq, B_WIDTH)
    return (o * jax.nn.silu(z)) @ w_out


def dense_chunk_attention(q, k, v, scale):
    bsz, seq, heads, dqk = q.shape
    nb = seq // QBLOCK
    qb = q.reshape(bsz, nb, QBLOCK, heads, dqk).transpose(1, 0, 2, 3, 4)
    starts = jnp.arange(nb, dtype=jnp.int32) * QBLOCK
    k_pos = jnp.arange(seq, dtype=jnp.int32)

    def attend(args):
        q_b, q0 = args
        logits = jnp.einsum("bqhd,bshd->bhqs", q_b, k).astype(jnp.float32) * scale
        mask = chunk_visible(q0 + jnp.arange(QBLOCK, dtype=jnp.int32), k_pos)
        logits = jnp.where(mask[None, None], logits, -jnp.inf)
        p = jax.nn.softmax(logits, axis=-1).astype(v.dtype)
        return jnp.einsum("bhqs,bshd->bqhd", p, v)

    o = lax.map(attend, (qb, starts))
    return o.transpose(1, 0, 2, 3, 4).reshape(bsz, seq, heads, v.shape[-1])


def mla_mixer(xn, positions, w_in, q_lat_norm, kv_lat_norm, w_uq, w_ukv, q_norm, k_norm, w_out):
    bsz, seq, _ = xn.shape
    cuts = np.cumsum([C_Q_LORA, C_KV_LORA, C_ROPE]).tolist()
    cq, ckv, kr, z = jnp.split(xn @ w_in, cuts, axis=-1)
    q = (rmsnorm(cq, q_lat_norm) @ w_uq).reshape(bsz, seq, C_HEADS, C_QK)
    kv = (rmsnorm(ckv, kv_lat_norm) @ w_ukv).reshape(bsz, seq, C_HEADS, C_NOPE + C_V)
    k_nope, v = kv[..., :C_NOPE], kv[..., C_NOPE:]
    k = jnp.concatenate([k_nope, jnp.broadcast_to(kr[:, :, None, :], (bsz, seq, C_HEADS, C_ROPE))], axis=-1)
    q = rmsnorm(q, q_norm)
    k = rmsnorm(k, k_norm)
    q = jnp.concatenate([q[..., :C_NOPE], rope(q[..., C_NOPE:], positions)], axis=-1)
    k = jnp.concatenate([k[..., :C_NOPE], rope(k[..., C_NOPE:], positions)], axis=-1)
    o = dense_chunk_attention(q, k, v, C_QK ** -0.5).reshape(bsz, seq, C_WIDTH)
    return (o * jax.nn.silu(z)) @ w_out


def setup_inputs(seed: int = 0) -> dict:
    key = jax.random.key(seed)
    ks = iter(jax.random.split(key, 32))
    f32 = jnp.float32

    def dense(shape, fan_in):
        return jax.random.normal(next(ks), shape, f32) * fan_in ** -0.5

    def gain(shape):
        return 1.0 + 0.02 * jax.random.normal(next(ks), shape, f32)

    x = jax.random.normal(next(ks), (BATCH, SEQ, D_MODEL), f32)
    offset = jax.random.randint(next(ks), (BATCH,), 0, 64, dtype=jnp.int32) * CHUNK
    positions = offset[:, None] + jnp.arange(SEQ, dtype=jnp.int32)[None, :]
    return {
        "x": x,
        "positions": positions,
        "a_norm": gain((N_A, D_MODEL)),
        "a_w_in": dense((N_A, D_MODEL, 4 * A_WIDTH), D_MODEL),
        "a_conv_w": dense((N_A, CONV_WIDTH, A_WIDTH), CONV_WIDTH),
        "a_conv_b": 0.02 * jax.random.normal(next(ks), (N_A, A_WIDTH), f32),
        "a_w_out": dense((N_A, A_WIDTH, D_MODEL), A_WIDTH),
        "b_norm": gain((N_B, D_MODEL)),
        "b_w_in": dense((N_B, D_MODEL, B_IN_COLS), D_MODEL),
        "b_q_norm": gain((N_B, B_HEAD_DIM)),
        "b_k_norm": gain((N_B, B_HEAD_DIM)),
        "b_w_out": dense((N_B, B_WIDTH, D_MODEL), B_WIDTH),
        "c_norm": gain((N_C, D_MODEL)),
        "c_w_in": dense((N_C, D_MODEL, C_IN_COLS), D_MODEL),
        "c_q_lat_norm": gain((N_C, C_Q_LORA)),
        "c_kv_lat_norm": gain((N_C, C_KV_LORA)),
        "c_w_uq": dense((N_C, C_Q_LORA, C_HEADS * C_QK), C_Q_LORA),
        "c_w_ukv": dense((N_C, C_KV_LORA, C_HEADS * (C_NOPE + C_V)), C_KV_LORA),
        "c_q_norm": gain((N_C, C_QK)),
        "c_k_norm": gain((N_C, C_QK)),
        "c_w_out": dense((N_C, C_WIDTH, D_MODEL), C_WIDTH),
    }


def reference(x, positions, a_norm, a_w_in, a_conv_w, a_conv_b, a_w_out,
              b_norm, b_w_in, b_q_norm, b_k_norm, b_w_out,
              c_norm, c_w_in, c_q_lat_norm, c_kv_lat_norm, c_w_uq, c_w_ukv, c_q_norm, c_k_norm, c_w_out):
    for i in range(DEPTH):
        kind, j = i % N_MIXERS, i // N_MIXERS
        if kind == 0:
            y = short_conv_mixer(rmsnorm(x, a_norm[j]), a_w_in[j], a_conv_w[j], a_conv_b[j], a_w_out[j])
        elif kind == 1:
            y = dsa_mixer(rmsnorm(x, b_norm[j]), positions, b_w_in[j], b_q_norm[j], b_k_norm[j], b_w_out[j])
        else:
            y = mla_mixer(rmsnorm(x, c_norm[j]), positions, c_w_in[j], c_q_lat_norm[j], c_kv_lat_norm[j],
                          c_w_uq[j], c_w_ukv[j], c_q_norm[j], c_k_norm[j], c_w_out[j])
        x = x + y
    return x
```

```cpp
#include <hip/hip_runtime.h>
#include <hip/hip_cooperative_groups.h>
#include <stdint.h>
#include <stdio.h>
namespace cg = cooperative_groups;

#define DI __device__ __forceinline__

typedef unsigned short u16;
using bf16x8 = __attribute__((ext_vector_type(8))) short;
using s16x4 = __attribute__((ext_vector_type(4))) short;
using f32x16 = __attribute__((ext_vector_type(16))) float;
using f32x4 = __attribute__((ext_vector_type(4))) float;
using f32x2 = __attribute__((ext_vector_type(2))) float;
using bf16x2v = __attribute__((ext_vector_type(2))) __bf16;
using u32x4v = __attribute__((ext_vector_type(4))) unsigned;
using u32x2v = __attribute__((ext_vector_type(2))) unsigned;

constexpr float EPS_ = 1e-6f;
constexpr float LOG2E_ = 1.4426950408889634f;

__device__ const float c_inv[32] = {
    1.000000000e+00f, 7.498942614e-01f, 5.623413324e-01f, 4.216965139e-01f, 3.162277639e-01f, 2.371373773e-01f,
    1.778279394e-01f, 1.333521307e-01f, 1.000000015e-01f, 7.498941571e-02f, 5.623413250e-02f, 4.216965288e-02f,
    3.162277490e-02f, 2.371373773e-02f, 1.778279431e-02f, 1.333521493e-02f, 9.999999776e-03f, 7.498941850e-03f,
    5.623413250e-03f, 4.216964822e-03f, 3.162277630e-03f, 2.371373586e-03f, 1.778279431e-03f, 1.333521446e-03f,
    1.000000047e-03f, 7.498942432e-04f, 5.623413017e-04f, 4.216965172e-04f, 3.162277571e-04f, 2.371373703e-04f,
    1.778279402e-04f, 1.333521504e-04f};

struct Params {
  const float* x; const int* pos;
  const float *a_norm, *a_w_in, *a_conv_w, *a_conv_b, *a_w_out;
  const float *b_norm, *b_w_in, *b_q_norm, *b_k_norm, *b_w_out;
  const float *c_norm, *c_w_in, *c_q_lat_norm, *c_kv_lat_norm, *c_w_uq, *c_w_ukv, *c_q_norm, *c_k_norm, *c_w_out;
  float* out;
  char* ws;
  DI u16* WaT0() const { return (u16*)(ws + 0l); }
  DI u16* WaoT0() const { return (u16*)(ws + 8388608l); }
  DI u16* WaT1() const { return (u16*)(ws + 10485760l); }
  DI u16* WaoT1() const { return (u16*)(ws + 18874368l); }
  DI u16* WbT() const { return (u16*)(ws + 20971520l); }
  DI u16* WboT() const { return (u16*)(ws + 30932992l); }
  DI u16* WcT() const { return (u16*)(ws + 33030144l); }
  DI u16* WuqT() const { return (u16*)(ws + 36700160l); }
  DI u16* WukvT() const { return (u16*)(ws + 38273024l); }
  DI u16* WcoT() const { return (u16*)(ws + 39321600l); }
  DI u16* xb() const { return (u16*)(ws + 41418752l); }
  DI u16* vb() const { return (u16*)(ws + 74973184l); }
  DI u16* szb() const { return (u16*)(ws + 108527616l); }
  DI u16* qreg() const { return (u16*)(ws + 142082048l); }
  DI u16* kreg() const { return (u16*)(ws + 192413696l); }
  DI u16* qib() const { return (u16*)(ws + 242745344l); }
  DI float2* rope() const { return (float2*)(ws + 259522560l); }
  DI unsigned* counters() const { return (unsigned*)(ws + 263716864l); }
  DI unsigned* bar() const { return (unsigned*)(ws + 263720960l); }
  DI float* rss() const { return (float*)(ws + 263737344l); }
  DI float* convPF() const { return (float*)(ws + 264130560l); }
  DI float* convUF() const { return (float*)(ws + 264654848l); }
  DI float* convUL() const { return (float*)(ws + 265179136l); }
  DI unsigned* mask() const { return (unsigned*)(ws + 0l); }
  DI u16* kib() const { return (u16*)(ws + 4194304l); }
  DI float* wif() const { return (float*)(ws + 6291456l); }
  DI float* krf() const { return (float*)(ws + 8388608l); }
  DI u16* cqb() const { return (u16*)(ws + 74973184l); }
  DI u16* ckvb() const { return (u16*)(ws + 87556096l); }
};

DI unsigned cvtpk(float lo, float hi) { f32x2 v = {lo, hi}; bf16x2v b = __builtin_convertvector(v, bf16x2v); return __builtin_bit_cast(unsigned, b); }
DI float bflo(unsigned w) { return __uint_as_float(w << 16); }
DI float bfhi(unsigned w) { return __uint_as_float(w & 0xFFFF0000u); }
DI float silu_f(float x) { return x / (1.f + __expf(-x)); }
DI f32x16 mfma32(bf16x8 a, bf16x8 b, f32x16 c) { return __builtin_amdgcn_mfma_f32_32x32x16_bf16(a, b, c, 0, 0, 0); }
DI f32x4 mfma16(bf16x8 a, bf16x8 b, f32x4 c) { return __builtin_amdgcn_mfma_f32_16x16x32_bf16(a, b, c, 0, 0, 0); }
DI uint4 pack8(const float* v) { uint4 r; r.x = cvtpk(v[0], v[1]); r.y = cvtpk(v[2], v[3]); r.z = cvtpk(v[4], v[5]); r.w = cvtpk(v[6], v[7]); return r; }
DI int otid() { int t = threadIdx.x; asm volatile("" : "+v"(t)); return t; }
DI float4 ld_nt4(const float* p) { const f32x4 v = __builtin_nontemporal_load((const f32x4*)p); return make_float4(v[0], v[1], v[2], v[3]); }
DI void st_nt4(void* p, uint4 v) { u32x4v w = {v.x, v.y, v.z, v.w}; __builtin_nontemporal_store(w, (u32x4v*)p); }
DI void st_nt2(void* p, uint2 v) { u32x2v w = {v.x, v.y}; __builtin_nontemporal_store(w, (u32x2v*)p); }
DI void st_wt16(void* p, uint4 v) { u32x4v w = {v.x, v.y, v.z, v.w}; asm volatile("global_store_dwordx4 %0, %1, off sc1\n\ts_nop 2" :: "v"(p), "v"(w) : "memory");     }
DI void st_wt8(void* p, uint2 v) { u32x2v w = {v.x, v.y}; asm volatile("global_store_dwordx2 %0, %1, off sc1\n\ts_nop 2" :: "v"(p), "v"(w) : "memory"); }
DI float shx(float v, int m) { return __shfl_xor(v, m, 64); }
DI unsigned shxu(unsigned v, int m) { return (unsigned)__shfl_xor((int)v, m, 64); }

constexpr int LDS_Q = 67584;
constexpr int LDS_RS = 157952;
constexpr int LDS_ITEM = 158464;
constexpr int LDS_UPREV = 158720;
constexpr int LDS_RS2 = 159232;
constexpr int LDS_TOTAL = 160256;
constexpr int CS_LD = 132;
constexpr int NT = 512;

DI int map_col(int kind, int n) {
  switch (kind) {
    case 1: return ((n >> 5) & 3) * 1024 + (n >> 7) * 32 + (n & 31);
    case 2: return n < 640 ? n : (n < 1664 ? n + 32 : (n < 1696 ? n - 1024 : -1));
    case 3: { int d = n & 127; return d < 96 ? (n >> 7) * 96 + d : -1; }
    case 4: return n < 4680 ? n : -1;
    default: return n;
  }
}

struct WJob { const float* W; u16* Wt; const float* gain; int K, Nsrc, ntn, kind, lt; };
DI WJob prep_job(const Params& p, int tile) {
  WJob j;
  int Np, base;
  if (tile < 1024)      { j.W = p.a_w_in; j.Wt = p.WaT0(); j.gain = p.a_norm; j.K = 1024; j.Nsrc = 4096; Np = 4096; j.kind = 1; base = 0; }
  else if (tile < 2048) { j.W = p.a_w_in + 1024 * 4096; j.Wt = p.WaT1(); j.gain = p.a_norm + 1024; j.K = 1024; j.Nsrc = 4096; Np = 4096; j.kind = 1; base = 1024; }
  else if (tile < 2304) { j.W = p.a_w_out; j.Wt = p.WaoT0(); j.gain = nullptr; j.K = 1024; j.Nsrc = 1024; Np = 1024; j.kind = 0; base = 2048; }
  else if (tile < 2560) { j.W = p.a_w_out + 1024 * 1024; j.Wt = p.WaoT1(); j.gain = nullptr; j.K = 1024; j.Nsrc = 1024; Np = 1024; j.kind = 0; base = 2304; }
  else if (tile < 3776) { j.W = p.b_w_in; j.Wt = p.WbT(); j.gain = p.b_norm; j.K = 1024; j.Nsrc = 4680; Np = 4864; j.kind = 4; base = 2560; }
  else if (tile < 4032) { j.W = p.b_w_out; j.Wt = p.WboT(); j.gain = nullptr; j.K = 1024; j.Nsrc = 1024; Np = 1024; j.kind = 0; base = 3776; }
  else if (tile < 4480) { j.W = p.c_w_in; j.Wt = p.WcT(); j.gain = p.c_norm; j.K = 1024; j.Nsrc = 1696; Np = 1792; j.kind = 2; base = 4032; }
  else if (tile < 4672) { j.W = p.c_w_uq; j.Wt = p.WuqT(); j.gain = p.c_q_lat_norm; j.K = 384; j.Nsrc = 1536; Np = 2048; j.kind = 3; base = 4480; }
  else if (tile < 4800) { j.W = p.c_w_ukv; j.Wt = p.WukvT(); j.gain = p.c_kv_lat_norm; j.K = 256; j.Nsrc = 2048; Np = 2048; j.kind = 0; base = 4672; }
  else                  { j.W = p.c_w_out; j.Wt = p.WcoT(); j.gain = nullptr; j.K = 1024; j.Nsrc = 1024; Np = 1024; j.kind = 0; base = 4800; }
  j.ntn = Np >> 6; j.lt = tile - base;
  return j;
}
DI void prep_load(const WJob& j, int t, float4 (&r)[4]) {
  const int tk = j.lt / j.ntn, tn = j.lt - tk * j.ntn;
  const int k0 = tk * 64, n0 = tn * 64, n4 = (t & 15) * 4, kq = t >> 4;
  const int ns = map_col(j.kind, n0 + n4);
#pragma unroll
  for (int i = 0; i < 4; ++i) {
    const int kl = kq + 16 * i;
    float4 v = make_float4(0.f, 0.f, 0.f, 0.f);
    if (ns >= 0) {
      v = ld_nt4(j.W + (long)(k0 + kl) * j.Nsrc + ns);
      if (j.gain) { const float g = j.gain[k0 + kl]; v.x *= g; v.y *= g; v.z *= g; v.w *= g; }
    }
    r[i] = v;
  }
}
DI void prep_store(const WJob& j, int t, const float4 (&r)[4], float* tl, bool active) {
  const int tk = j.lt / j.ntn, tn = j.lt - tk * j.ntn;
  const int k0 = tk * 64, n0 = tn * 64, n4 = (t & 15) * 4, kq = t >> 4;
  if (active) {
#pragma unroll
    for (int i = 0; i < 4; ++i) {
      float* d = tl + (kq + 16 * i) * 68 + n4;
      *(float4*)d = r[i];
    }
  }
  __syncthreads();
  if (active) {
#pragma unroll
    for (int jj = 0; jj < 2; ++jj) {
      const int c = t + 256 * jj, n_l = c >> 3, kc = c & 7;
      float v[8];
#pragma unroll
      for (int e = 0; e < 8; ++e) v[e] = tl[(kc * 8 + e) * 68 + n_l];
      *(uint4*)(j.Wt + (long)(n0 + n_l) * j.K + k0 + kc * 8) = pack8(v);
    }
  }
  __syncthreads();
}

DI void phase_prep(const Params& p, char* smem) {
  const int tp_ = otid();
  const int t = tp_ & 255, hb = tp_ >> 8;
  float* tl = (float*)(smem + hb * 17408);
  {
    const int stride = gridDim.x * 2;
    int tile = blockIdx.x * 2 + hb;
    float4 r[4], rn[4];
    WJob j = prep_job(p, min(tile, 5055));
    if (tile < 5056) prep_load(j, t, r);
    const int l = tp_ & 63;
    const int nw = gridDim.x * 8;
    int row = blockIdx.x * 8 + (tp_ >> 6);
    for (int tile0 = blockIdx.x * 2; tile0 < 5056 || row < 16384; tile0 += stride, tile += stride, row += nw) {
      const int nxt = tile + stride;
      WJob jn = prep_job(p, min(nxt, 5055));
      if (nxt < 5056) prep_load(jn, t, rn);
      float4 va[4];
      if (row < 16384) {
#pragma unroll
        for (int i = 0; i < 4; ++i) va[i] = ld_nt4(p.x + ((long)row * 256 + l + 64 * i) * 4);
      }
      prep_store(j, t, r, tl, tile < 5056);
      if (row < 16384) {
        float ssq = 0.f;
#pragma unroll
        for (int i = 0; i < 4; ++i) {
          const float4 v = va[i];
          uint2 ob; ob.x = cvtpk(v.x, v.y); ob.y = cvtpk(v.z, v.w);
          ((uint2*)p.xb())[(long)row * 256 + l + 64 * i] = ob;
          ssq += v.x * v.x + v.y * v.y + v.z * v.z + v.w * v.w;
        }
        ssq += shx(ssq, 1); ssq += shx(ssq, 2); ssq += shx(ssq, 4); ssq += shx(ssq, 8); ssq += shx(ssq, 16); ssq += shx(ssq, 32);
        if (l == 0) p.rss()[row] = ssq;
      }
      j = jn;
#pragma unroll
      for (int i = 0; i < 4; ++i) r[i] = rn[i];
    }
  }
  const long nthr = (long)gridDim.x * NT, tid = (long)blockIdx.x * NT + threadIdx.x;
  for (long i = tid; i < 5 * 16384; i += nthr) p.rss()[16384 + i] = 0.f;
  for (long i = tid; i < (long)16384 * 32; i += nthr) {
    const int j = (int)(i >> 14), m = (int)(i & 16383);
    const float ang = (float)p.pos[m] * c_inv[j];
    double f = (double)ang * 0.15915494309189535;
    f -= __builtin_rint(f);
    const float r = (float)(f * 6.283185307179586);
    p.rope()[i] = make_float2(cosf(r), sinf(r));
  }
}

constexpr int HT_ = 128 * 64;
DI int lds_byte(int r, int c) {
  const int st = (r >> 4) * 2 + (c >> 5), rr = r & 15, cc = c & 31, ob = rr * 64 + cc * 2;
  return st * 1024 + (ob ^ (((ob >> 9) & 1) << 5));
}
DI void stage_rc(int b, int& R, int& C) {
  const int st = b / 1024, sb = b % 1024, swz = sb ^ (((sb >> 9) & 1) << 5);
  R = (st >> 1) * 16 + swz / 64; C = (st & 1) * 32 + (swz % 64) / 2;
}
typedef f32x4 acc_t[2][2][4][2];

DI void gemm256(const u16* __restrict__ A, long arow0, long arow1, const u16* __restrict__ Bt, int bcol, int K, char* smem, acc_t& acc) {
  u16* shm = (u16*)smem;
#define SA(b, h) (shm + ((b) * 2 + (h)) * HT_)
#define SB(b, h) (shm + (4 + (b) * 2 + (h)) * HT_)
#define OPAQUE(v) asm volatile("" : "+v"(v))
#define STAGE(P, BASE, br, kt) do { const char* _gb = (const char*)(BASE + (long)(br) * K + (long)(kt) * 64);   \
      int _t16 = t16; OPAQUE(_t16);                                                                          \
      __builtin_amdgcn_global_load_lds((const unsigned*)(_gb + goff0),                                       \
        (__attribute__((address_space(3))) unsigned*)((char*)(P) + _t16), 16, 0, 0);                         \
      __builtin_amdgcn_global_load_lds((const unsigned*)(_gb + goff1),                                       \
        (__attribute__((address_space(3))) unsigned*)((char*)(P) + _t16 + 8192), 16, 0, 0); } while (0)
#define LDA(dst, b, h) do { int _ab = abase; OPAQUE(_ab); const char* _pa = (const char*)SA(b, h) + _ab;      \
    for (int m = 0; m < 4; ++m) for (int k = 0; k < 2; ++k)                                                  \
      dst[m][k] = *reinterpret_cast<const bf16x8*>(_pa + m * 2048 + k * 1024); } while (0)
#define LDB(dst, b, h) do { int _bb = bbase; OPAQUE(_bb); const char* _pb = (const char*)SB(b, h) + _bb;      \
    for (int n = 0; n < 2; ++n) for (int k = 0; k < 2; ++k)                                                  \
      dst[n][k] = *reinterpret_cast<const bf16x8*>(_pb + n * 2048 + k * 1024); } while (0)
#define MMA(ai, bj, At, Bt_) do { __builtin_amdgcn_s_setprio(1);                                              \
    for (int m = 0; m < 4; ++m) for (int n = 0; n < 2; ++n) for (int k = 0; k < 2; ++k)                       \
      acc[ai][bj][m][n] = __builtin_amdgcn_mfma_f32_16x16x32_bf16(Bt_[n][k], At[m][k], acc[ai][bj][m][n], 0, 0, 0); \
    __builtin_amdgcn_s_setprio(0); } while (0)
#define WAIT_V(n) asm volatile("s_waitcnt vmcnt(" #n ")" ::: "memory")
#define WAIT_L(n) asm volatile("s_waitcnt lgkmcnt(" #n ")" ::: "memory")
#define BAR __builtin_amdgcn_s_barrier()
#define SCHED __builtin_amdgcn_sched_barrier(0)
  const int tid_ = otid();
  const int wid = tid_ >> 6, lane = tid_ & 63, wr = wid >> 2, wc = wid & 3, fr = lane & 15, fq = lane >> 4;
#pragma unroll
  for (int a = 0; a < 2; ++a)
#pragma unroll
    for (int b = 0; b < 2; ++b)
#pragma unroll
      for (int m = 0; m < 4; ++m)
#pragma unroll
        for (int n = 0; n < 2; ++n) acc[a][b][m][n] = f32x4{0.f, 0.f, 0.f, 0.f};
  bf16x8 At[4][2], B0[2][2], B1[2][2];
  const int nt = K / 64;
  unsigned goff0, goff1;
  { int r_, c_; stage_rc(tid_ * 16, r_, c_); goff0 = (unsigned)(r_ * K + c_) * 2u; stage_rc(tid_ * 16 + 8192, r_, c_); goff1 = (unsigned)(r_ * K + c_) * 2u; }
  const int swz_ = lds_byte(fr, fq * 8);
  const int abase = wr * 8192 + swz_, bbase = wc * 4096 + swz_;
  const int t16 = tid_ * 16;
  const int bcol1 = bcol + 128;
  STAGE(SB(0, 0), Bt, bcol, 0); STAGE(SA(0, 0), A, arow0, 0);
  STAGE(SB(0, 1), Bt, bcol1, 0); STAGE(SA(0, 1), A, arow1, 0);
  if (wr == 1) BAR;
  WAIT_V(4); BAR;
  STAGE(SB(1, 0), Bt, bcol, 1); STAGE(SA(1, 0), A, arow0, 1); STAGE(SB(1, 1), Bt, bcol1, 1);
  WAIT_V(6); BAR;
  for (int t = 0; t < nt - 2; t += 2) {
    LDB(B0, 0, 0); SCHED; LDA(At, 0, 0); STAGE(SA(1, 1), A, arow1, t + 1);
    WAIT_L(8); BAR; WAIT_L(0); MMA(0, 0, At, B0); BAR; SCHED;
    LDB(B1, 0, 1); STAGE(SB(0, 0), Bt, bcol, t + 2);
    BAR; WAIT_L(0); MMA(0, 1, At, B1); BAR;
    LDA(At, 0, 1); STAGE(SA(0, 0), A, arow0, t + 2);
    BAR; WAIT_L(0); MMA(1, 0, At, B0); BAR; SCHED;
    STAGE(SB(0, 1), Bt, bcol1, t + 2);
    WAIT_V(6); BAR; MMA(1, 1, At, B1); BAR;
    LDB(B0, 1, 0); SCHED; LDA(At, 1, 0); STAGE(SA(0, 1), A, arow1, t + 2);
    WAIT_L(8); BAR; WAIT_L(0); MMA(0, 0, At, B0); BAR; SCHED;
    LDB(B1, 1, 1); STAGE(SB(1, 0), Bt, bcol, t + 3);
    BAR; WAIT_L(0); MMA(0, 1, At, B1); BAR;
    LDA(At, 1, 1); STAGE(SA(1, 0), A, arow0, t + 3);
    BAR; WAIT_L(0); MMA(1, 0, At, B0); BAR; SCHED;
    STAGE(SB(1, 1), Bt, bcol1, t + 3);
    WAIT_V(6); BAR; MMA(1, 1, At, B1); BAR;
  }
  { LDB(B0, 0, 0); LDA(At, 0, 0); STAGE(SA(1, 1), A, arow1, nt - 1);
    BAR; WAIT_L(0); MMA(0, 0, At, B0); BAR;
    LDB(B1, 0, 1); BAR; WAIT_L(0); MMA(0, 1, At, B1); BAR;
    LDA(At, 0, 1); WAIT_V(4); BAR; WAIT_L(0); MMA(1, 0, At, B0); MMA(1, 1, At, B1); BAR; }
  { LDB(B0, 1, 0); LDA(At, 1, 0); WAIT_V(2); BAR; WAIT_L(0); MMA(0, 0, At, B0); BAR;
    LDB(B1, 1, 1); WAIT_V(0); BAR; WAIT_L(0); MMA(0, 1, At, B1); BAR;
    LDA(At, 1, 1); BAR; WAIT_L(0); MMA(1, 0, At, B0); MMA(1, 1, At, B1); BAR; }
  if (wr == 0) BAR;
#undef SA
#undef SB
#undef STAGE
#undef OPAQUE
#undef LDA
#undef LDB
#undef MMA
#undef WAIT_V
#undef WAIT_L
#undef BAR
#undef SCHED
  __syncthreads();
}

DI void dump_half(const acc_t& acc, int ai, char* smem) {
  const int tid_ = otid();
  const int wid = tid_ >> 6, lane = tid_ & 63, wr = wid >> 2, wc = wid & 3, fr = lane & 15, fq = lane >> 4;
#pragma unroll
  for (int bj = 0; bj < 2; ++bj) {
    float* Cq = (float*)(smem + bj * LDS_Q);
#pragma unroll
    for (int m = 0; m < 4; ++m)
#pragma unroll
      for (int n = 0; n < 2; ++n)
        *(f32x4*)(Cq + (wr * 64 + m * 16 + fr) * CS_LD + wc * 32 + n * 16 + fq * 4) = acc[ai][bj][m][n];
  }
}

enum { EPI_RES = 0, EPI_CONV = 1, EPI_BIN = 2, EPI_CIN = 3, EPI_UQ = 4, EPI_UKV = 5 };

DI void epi_res(const Params& p, char* smem, const float* rs, int t, int m0, int n0, float* rss_next, const float* res_in) {
  const float* Cs = (const float*)smem;
  const int c4 = (t & 31) * 4;
#pragma unroll 8
  for (int ps = 0; ps < 16; ++ps) {
    const int row = (t >> 5) + 8 * ps;
    const float4 c = *(const float4*)(Cs + row * CS_LD + c4);
    const long o = (long)(m0 + row) * 1024 + n0 + c4;
    const uint2 xr = *(const uint2*)(p.xb() + o);
    float4 v = make_float4(bflo(xr.x) + c.x, bfhi(xr.x) + c.y, bflo(xr.y) + c.z, bfhi(xr.y) + c.w);
    if (res_in == nullptr) {
      { f32x4 w_ = {v.x, v.y, v.z, v.w}; __builtin_nontemporal_store(w_, (f32x4*)(p.out + o)); }
    } else {
      uint2 b; b.x = cvtpk(v.x, v.y); b.y = cvtpk(v.z, v.w);
      st_wt8(p.xb() + o, b);
    }
    if (rss_next) {
      float q = v.x * v.x + v.y * v.y + v.z * v.z + v.w * v.w;
      q += shx(q, 1); q += shx(q, 2); q += shx(q, 4); q += shx(q, 8); q += shx(q, 16);
      if ((t & 31) == 0) atomicAdd(rss_next + m0 + row, q);
    }
  }
}

DI void epi_conv(const Params& p, char* smem, const float* rs, int t, int layer, int m0h, int ai, int pm, int nt, float* uprev) {
  const float* Cs = (const float*)smem;
  const int c4 = (t & 7) * 4;
  const int ch = nt * 32 + c4;
  const float4 w0 = *(const float4*)(p.a_conv_w + layer * 3072 + ch);
  const float4 w1 = *(const float4*)(p.a_conv_w + layer * 3072 + 1024 + ch);
  const float4 w2 = *(const float4*)(p.a_conv_w + layer * 3072 + 2048 + ch);
  const float4 cb = *(const float4*)(p.a_conv_b + layer * 1024 + ch);
  const bool seq_start = ((m0h & 2047) == 0);
#pragma unroll 2
  for (int ps = 0; ps < 4; ++ps) {
    const int row = (t >> 3) + 32 * ps;
    const float ra = rs[row];
    const float* c0 = Cs + row * CS_LD + c4;
    const float4 bg = *(const float4*)(c0);
    const float4 cga = *(const float4*)(c0 + 32), hva = *(const float4*)(c0 + 64);
    const float4 z = *(const float4*)(c0 + 96);
    const float ra2 = ra * ra;
    const float4 ua = make_float4(cga.x * hva.x * ra2, cga.y * hva.y * ra2, cga.z * hva.z * ra2, cga.w * hva.w * ra2);
    const float4 pg = make_float4(bg.x * ra * silu_f(z.x * ra), bg.y * ra * silu_f(z.y * ra), bg.z * ra * silu_f(z.z * ra), bg.w * ra * silu_f(z.w * ra));
    if (row >= 126) {
      if (ai == 0) *(float4*)(uprev + (row - 126) * 32 + c4) = ua;
      else *(float4*)(p.convUL() + ((long)pm * 2 + (row - 126)) * 1024 + ch) = ua;
    }
    float4 ub, uc;
    bool defer = false;
    if (row >= 2) {
      const float rb = rs[row - 1], rc = rs[row - 2];
      const float rb2 = rb * rb, rc2 = rc * rc;
      const float4 cgb = *(const float4*)(c0 - CS_LD + 32), hvb = *(const float4*)(c0 - CS_LD + 64);
      const float4 cgc = *(const float4*)(c0 - 2 * CS_LD + 32), hvc = *(const float4*)(c0 - 2 * CS_LD + 64);
      ub = make_float4(cgb.x * hvb.x * rb2, cgb.y * hvb.y * rb2, cgb.z * hvb.z * rb2, cgb.w * hvb.w * rb2);
      uc = make_float4(cgc.x * hvc.x * rc2, cgc.y * hvc.y * rc2, cgc.z * hvc.z * rc2, cgc.w * hvc.w * rc2);
    } else if (ai == 1) {
      const float4 p1 = *(const float4*)(uprev + 32 + c4), p0 = *(const float4*)(uprev + c4);
      if (row == 1) {
        const float rb = rs[0]; const float rb2 = rb * rb;
        const float4 cgb = *(const float4*)(c0 - CS_LD + 32), hvb = *(const float4*)(c0 - CS_LD + 64);
        ub = make_float4(cgb.x * hvb.x * rb2, cgb.y * hvb.y * rb2, cgb.z * hvb.z * rb2, cgb.w * hvb.w * rb2);
        uc = p1;
      } else { ub = p1; uc = p0; }
    } else if (seq_start) {
      uc = make_float4(0.f, 0.f, 0.f, 0.f);
      if (row == 1) {
        const float rb = rs[0]; const float rb2 = rb * rb;
        const float4 cgb = *(const float4*)(c0 - CS_LD + 32), hvb = *(const float4*)(c0 - CS_LD + 64);
        ub = make_float4(cgb.x * hvb.x * rb2, cgb.y * hvb.y * rb2, cgb.z * hvb.z * rb2, cgb.w * hvb.w * rb2);
      } else ub = uc;
    } else {
      defer = true;
      ub = uc = make_float4(0.f, 0.f, 0.f, 0.f);
      *(float4*)(p.convPF() + ((long)pm * 2 + row) * 1024 + ch) = pg;
      *(float4*)(p.convUF() + ((long)pm * 2 + row) * 1024 + ch) = ua;
    }
    if (!defer) {
      const float y0 = (w0.x * uc.x + w1.x * ub.x + w2.x * ua.x + cb.x) * pg.x;
      const float y1 = (w0.y * uc.y + w1.y * ub.y + w2.y * ua.y + cb.y) * pg.y;
      const float y2 = (w0.z * uc.z + w1.z * ub.z + w2.z * ua.z + cb.z) * pg.z;
      const float y3 = (w0.w * uc.w + w1.w * ub.w + w2.w * ua.w + cb.w) * pg.w;
      uint2 o; o.x = cvtpk(y0, y1); o.y = cvtpk(y2, y3);
      st_wt8(p.vb() + ((long)(m0h + row)) * 1024 + ch, o);
    }
  }
}

DI void conv_fixup(const Params& p, int layer, int pm) {
  if ((pm & 7) != 0) {
    for (int idx = otid(); idx < 2048; idx += NT) {
      const int row = idx >> 10, ch = idx & 1023;
      const float* ULp = p.convUL() + ((long)(pm - 1) * 2) * 1024 + ch;
      const float uf0 = p.convUF()[((long)pm * 2) * 1024 + ch];
      const float ufr = p.convUF()[((long)pm * 2 + row) * 1024 + ch];
      const float u_m1 = (row == 0) ? ULp[1024] : uf0;
      const float u_m2 = (row == 0) ? ULp[0] : ULp[1024];
      const float y = p.a_conv_w[layer * 3072 + ch] * u_m2 + p.a_conv_w[layer * 3072 + 1024 + ch] * u_m1 +
                      p.a_conv_w[layer * 3072 + 2048 + ch] * ufr + p.a_conv_b[layer * 1024 + ch];
      const float o = y * p.convPF()[((long)pm * 2 + row) * 1024 + ch];
      p.vb()[((long)pm * 256 + row) * 1024 + ch] = (u16)(cvtpk(o, 0.f) & 0xFFFFu);
    }
    asm volatile("s_waitcnt vmcnt(0)" ::: "memory");
    __syncthreads();
  }
}

DI u16* vT1_ptr(const Params& p, int bh) {
  return (bh < 64) ? p.qreg() + 16777216 + (long)bh * 131072 : p.kreg() + 16777216 + (long)(bh - 64) * 131072;
}

template <bool SILU>
DI void epi_rowwise_bf16(char* smem, const float* rs, int t, u16* dst, int ld, int m0, int col0, float* rss_acc) {
  const float* Cs = (const float*)smem;
  const int c4 = (t & 31) * 4;
#pragma unroll 4
  for (int ps = 0; ps < 16; ++ps) {
    const int row = (t >> 5) + 8 * ps;
    const float rr = rs[row];
    const float4 c = *(const float4*)(Cs + row * CS_LD + c4);
    float a = c.x * rr, b = c.y * rr, cc = c.z * rr, d = c.w * rr;
    if (SILU) { a = silu_f(a); b = silu_f(b); cc = silu_f(cc); d = silu_f(d); }
    uint2 o; o.x = cvtpk(a, b); o.y = cvtpk(cc, d);
    st_wt8(dst + (long)(m0 + row) * ld + col0 + c4, o);
    if (rss_acc) {
      float q = a * a + b * b + cc * cc + d * d;
      q += shx(q, 1); q += shx(q, 2); q += shx(q, 4); q += shx(q, 8); q += shx(q, 16);
      if ((t & 31) == 0) atomicAdd(rss_acc + m0 + row, q);
    }
  }
}

struct VReg { uint4 v[8]; };
DI void epi_vT_read(char* smem, const float* rs, int colc, int rh, VReg& vr) {
  const float* Cs = (const float*)smem;
#pragma unroll
  for (int i8 = 0; i8 < 8; ++i8) {
    float v[8];
#pragma unroll
    for (int e = 0; e < 8; ++e) { const int row = rh * 64 + i8 * 8 + e; v[e] = Cs[row * CS_LD + colc] * rs[row]; }
    vr.v[i8] = pack8(v);
  }
}
DI void vT_park(char* smem, int trow, int tcol, const VReg& vr) {
  float* Cs = (float*)smem;
#pragma unroll
  for (int i8 = 0; i8 < 8; ++i8) *(uint4*)(Cs + trow * CS_LD + tcol + 4 * i8) = vr.v[i8];
}

DI void row_scale_store(const float* cr, u16* dst, int n4, float sc, const float* g) {
#pragma unroll
  for (int i = 0; i < n4; ++i) {
    const float4 f = *(const float4*)(cr + 4 * i);
    float4 gg = make_float4(1.f, 1.f, 1.f, 1.f);
    if (g) gg = *(const float4*)(g + 4 * i);
    uint2 o; o.x = cvtpk(f.x * sc * gg.x, f.y * sc * gg.y); o.y = cvtpk(f.z * sc * gg.z, f.w * sc * gg.w);
    *(uint2*)(dst + 4 * i) = o;
  }
}
DI void rope_store(const float* srcA, const float* srcB, u16* dstA, u16* dstB, int half, float sc, const float* ga, const float* gb,
                   const float2* rp, int rstep, float post) {
#pragma unroll
  for (int j4 = 0; j4 < half / 4; ++j4) {
    const float4 a = *(const float4*)(srcA + 4 * j4), b = *(const float4*)(srcB + 4 * j4);
    float4 g1 = make_float4(1.f, 1.f, 1.f, 1.f), g2 = g1;
    if (ga) { g1 = *(const float4*)(ga + 4 * j4); g2 = *(const float4*)(gb + 4 * j4); }
    const float2 c0 = rp[(long)(4 * j4) * rstep], c1 = rp[(long)(4 * j4 + 1) * rstep], c2 = rp[(long)(4 * j4 + 2) * rstep], c3 = rp[(long)(4 * j4 + 3) * rstep];
    const float a0 = a.x * sc * g1.x, a1 = a.y * sc * g1.y, a2 = a.z * sc * g1.z, a3 = a.w * sc * g1.w;
    const float b0 = b.x * sc * g2.x, b1 = b.y * sc * g2.y, b2 = b.z * sc * g2.z, b3 = b.w * sc * g2.w;
    uint2 oa, ob;
    oa.x = cvtpk((a0 * c0.x - b0 * c0.y) * post, (a1 * c1.x - b1 * c1.y) * post);
    oa.y = cvtpk((a2 * c2.x - b2 * c2.y) * post, (a3 * c3.x - b3 * c3.y) * post);
    ob.x = cvtpk((b0 * c0.x + a0 * c0.y) * post, (b1 * c1.x + a1 * c1.y) * post);
    ob.y = cvtpk((b2 * c2.x + a2 * c2.y) * post, (b3 * c3.x + a3 * c3.y) * post);
    *(uint2*)(dstA + 4 * j4) = oa;
    *(uint2*)(dstB + 4 * j4) = ob;
  }
}
DI float row_ssq(const float* cr, int n4) {
  float s = 0.f;
#pragma unroll 4
  for (int i = 0; i < n4; ++i) { const float4 f = *(const float4*)(cr + 4 * i); s += f.x * f.x + f.y * f.y + f.z * f.z + f.w * f.w; }
  return s;
}

DI void epi_bin(const Params& p, char* smem, const float* rs, int t, int m0, int nt, VReg& vr) {
  const float* Cs = (const float*)smem;
  const int bidx = m0 >> 11, s0 = m0 & 2047;
  if (nt < 16) {
    const int row = t & 127, hh = t >> 7;
    const bool isq = nt < 8;
    const int head = (nt & 7) * 2 + hh;
    const float* cr = Cs + row * CS_LD + hh * 64;
    const float ssq = row_ssq(cr, 16);
    const float rr = rs[row];
    const float sc = rr * rsqrtf(rr * rr * ssq * (1.f / 64.f) + EPS_);
    const float* gn = isq ? p.b_q_norm : p.b_k_norm;
    const float post = isq ? 0.125f * LOG2E_ : 1.f;
    const int gm = m0 + row;
    rope_store(cr, cr + 32, (u16*)const_cast<float*>(cr), (u16*)const_cast<float*>(cr + 32), 32, sc, gn, gn + 32, p.rope() + gm, 16384, post);
  } else if (nt < 24) {
    epi_vT_read(smem, rs, t & 127, t >> 7, vr);
  } else if (nt < 32) {
    epi_rowwise_bf16<true>(smem, rs, t, p.szb(), 1024, m0, (nt - 24) * 128, nullptr);
  } else if (nt < 36) {
    const int row = t & 127, hh = t >> 7;
    const float* cr = Cs + row * CS_LD + hh * 64;
    const float rr = rs[row];
    const int gm = m0 + row;
    rope_store(cr, cr + 16, (u16*)const_cast<float*>(cr), (u16*)const_cast<float*>(cr + 16), 16, rr, nullptr, nullptr, p.rope() + gm, 32768, 1.f);
    row_scale_store(cr + 32, (u16*)const_cast<float*>(cr + 32), 8, rr, nullptr);
  } else if (nt == 36) {
    if (t < 128) {
      const int row = t;
      const float* cr = Cs + row * CS_LD;
      const float rr = rs[row];
      const int gm = m0 + row;
      rope_store(cr, cr + 16, (u16*)const_cast<float*>(cr), (u16*)const_cast<float*>(cr + 16), 16, rr, nullptr, nullptr, p.rope() + gm, 32768, 1.f);
      row_scale_store(cr + 32, (u16*)const_cast<float*>(cr + 32), 8, rr, nullptr);
    } else {
      const int row = t - 128;
      const float* cr = Cs + row * CS_LD + 64;
      const float sc = rs[row] * 0.044194173824159216f;
      const float4 f0 = *(const float4*)(cr), f1 = *(const float4*)(cr + 4);
      float* dst = p.wif() + (long)(m0 + row) * 8;
      *(float4*)(dst) = make_float4(f0.x * sc, f0.y * sc, f0.z * sc, f0.w * sc);
      *(float4*)(dst + 4) = make_float4(f1.x * sc, f1.y * sc, f1.z * sc, f1.w * sc);
    }
  }
}

DI void copy_bin(const Params& p, char* smem, int t, int m0, int nt, const VReg& vr) {
  const float* Cs = (const float*)smem;
  const int bidx = m0 >> 11, s0 = m0 & 2047;
  if (nt < 16) {
    u16* base = (nt < 8 ? p.qreg() : p.kreg());
#pragma unroll
    for (int hh = 0; hh < 2; ++hh) {
      u16* dst = base + ((long)((bidx * 16 + (nt & 7) * 2 + hh) * 2048 + s0)) * 64;
#pragma unroll
      for (int it = 0; it < 4; ++it) {
        const int c = t + 256 * it, row = c >> 3, ch = c & 7;
        const uint4 v = *(const uint4*)(Cs + row * CS_LD + hh * 64 + 4 * ch + (ch >= 4 ? 16 : 0));
        st_wt16(dst + (long)c * 8, v);
      }
    }
  } else if (nt < 24) {
    vT_park(smem, t & 127, (t >> 7) * 32, vr);
  } else if (nt >= 32 && nt < 36) {
#pragma unroll
    for (int hh = 0; hh < 2; ++hh) {
      u16* dst = p.qib() + ((long)m0 * 8 + (nt - 32) * 2 + hh) * 64;
#pragma unroll
      for (int it = 0; it < 4; ++it) {
        const int c = t + 256 * it, row = c >> 3, ch = c & 7;
        const uint4 v = *(const uint4*)(Cs + row * CS_LD + hh * 64 + 4 * ch + (ch >= 4 ? 16 : (ch >= 2 ? 8 : 0)));
        st_wt16(dst + (long)row * 512 + ch * 8, v);
      }
    }
  } else if (nt == 36) {
    u16* dst = p.kib() + (long)m0 * 64;
#pragma unroll
    for (int it = 0; it < 4; ++it) {
      const int c = t + 256 * it, row = c >> 3, ch = c & 7;
      const uint4 v = *(const uint4*)(Cs + row * CS_LD + 4 * ch + (ch >= 4 ? 16 : (ch >= 2 ? 8 : 0)));
      st_wt16(dst + (long)c * 8, v);
    }
  }
}

DI void copy2_bin(const Params& p, char* smem, int t, int m0, int nt) {
  if (nt >= 16 && nt < 24) {
    const float* Cs = (const float*)smem;
    const int bidx = m0 >> 11, s0 = m0 & 2047;
#pragma unroll
    for (int it = 0; it < 8; ++it) {
      const int c = t + 256 * it, dvr = c >> 4, ch = c & 15;
      const uint4 v = *(const uint4*)(Cs + dvr * CS_LD + 4 * ch);
      st_wt16(vT1_ptr(p, bidx * 16 + (nt - 16) * 2 + (dvr >> 6)) + (long)(dvr & 63) * 2048 + s0 + ch * 8, v);
    }
  }
}

DI void epi_cin(const Params& p, char* smem, const float* rs, int t, int m0, int nt) {
  if (nt < 3) epi_rowwise_bf16<false>(smem, rs, t, p.cqb(), 384, m0, nt * 128, p.rss() + 4 * 16384);
  else if (nt < 5) epi_rowwise_bf16<false>(smem, rs, t, p.ckvb(), 256, m0, (nt - 3) * 128, p.rss() + 5 * 16384);
  else if (nt < 13) epi_rowwise_bf16<true>(smem, rs, t, p.szb(), 1024, m0, (nt - 5) * 128, nullptr);
  else {
    const float* Cs = (const float*)smem;
    const int c4 = (t & 7) * 4;
#pragma unroll
    for (int ps = 0; ps < 4; ++ps) {
      const int row = (t >> 3) + 32 * ps;
      const float rr = rs[row];
      const float4 c = *(const float4*)(Cs + row * CS_LD + c4);
      *(float4*)(p.krf() + (long)(m0 + row) * 32 + c4) = make_float4(c.x * rr, c.y * rr, c.z * rr, c.w * rr);
    }
  }
}

DI void epi_uq(const Params& p, char* smem, const float* rs, int t, int m0, int head) {
  const float* Cs = (const float*)smem;
  const int row = t & 127, hf = t >> 7;
  const float* cr = Cs + row * CS_LD;
  const float ssq = row_ssq(cr, 24);
  const float rr = rs[row];
  const float sc = rr * rsqrtf(rr * rr * ssq * (1.f / 96.f) + EPS_) * (0.10206207261596575f * LOG2E_);
  const int gm = m0 + row;
  const float* gn = p.c_q_norm;
  float* cw = const_cast<float*>(cr);
  __syncthreads();
  if (hf == 0) {
    row_scale_store(cr, (u16*)cw, 12, sc, gn);
  } else {
    row_scale_store(cr + 48, (u16*)(cw + 48), 4, sc, gn + 48);
    rope_store(cr + 64, cr + 80, (u16*)(cw + 64), (u16*)(cw + 80), 16, sc, gn + 64, gn + 80, p.rope() + gm, 32768, 1.f);
  }
}
DI void copy_uq(const Params& p, char* smem, int t, int m0, int head) {
  const float* Cs = (const float*)smem;
  u16* dst = p.qreg() + ((long)(((m0 >> 11) * 16 + head) * 2048 + (m0 & 2047))) * 96;
#pragma unroll
  for (int it = 0; it < 6; ++it) {
    const int c = t + 256 * it, row = c / 12, ch = c - row * 12;
    const int slot = 4 * ch + (ch >= 10 ? 40 : (ch >= 8 ? 32 : (ch >= 6 ? 24 : 0)));
    const uint4 v = *(const uint4*)(Cs + row * CS_LD + slot);
    st_wt16(dst + (long)c * 8, v);
  }
}

DI void epi_ukv(const Params& p, char* smem, const float* rs, int t, int m0, int head, VReg& vr) {
  const float* Cs = (const float*)smem;
  const int bidx = m0 >> 11, s0 = m0 & 2047;
  if (t < 128) {
    const int row = t, gm = m0 + row;
    const float* cr = Cs + row * CS_LD;
    const float rr = rs[row];
    const float* kr = p.krf() + (long)gm * 32;
    const float ssq = rr * rr * row_ssq(cr, 16) + row_ssq(kr, 8);
    const float sc = rsqrtf(ssq * (1.f / 96.f) + EPS_);
    const float* gn = p.c_k_norm;
    float* cw = const_cast<float*>(cr);
    row_scale_store(cr, (u16*)cw, 16, rr * sc, gn);
    rope_store(kr, kr + 16, (u16*)(cw + 32), (u16*)(cw + 40), 16, sc, gn + 64, gn + 80, p.rope() + gm, 32768, 1.f);
  } else {
    const int u = t - 128;
    epi_vT_read(smem, rs, 64 + (u & 63), u >> 6, vr);
  }
}

DI void copy_ukv(const Params& p, char* smem, int t, int m0, int head, const VReg& vr) {
  const float* Cs = (const float*)smem;
  if (t >= 128) { const int u = t - 128; vT_park(smem, 2 * (u & 63) + (u >> 6), 64, vr); }
  u16* dst = p.kreg() + ((long)(((m0 >> 11) * 16 + head) * 2048 + (m0 & 2047))) * 96;
#pragma unroll
  for (int it = 0; it < 6; ++it) {
    const int c = t + 256 * it, row = c / 12, ch = c - row * 12;
    const uint4 v = *(const uint4*)(Cs + row * CS_LD + 4 * ch);
    st_wt16(dst + (long)c * 8, v);
  }
}

DI void copy2_ukv(const Params& p, char* smem, int t, int m0, int head) {
  const float* Cs = (const float*)smem;
  u16* base = (u16*)p.out + (long)((m0 >> 11) * 16 + head) * 131072 + (m0 & 2047);
#pragma unroll
  for (int it = 0; it < 4; ++it) {
    const int c = t + 256 * it, dvr = c >> 4, ch = c & 15;
    const uint4 v = *(const uint4*)(Cs + (2 * dvr + (ch >> 3)) * CS_LD + 64 + 4 * (ch & 7));
    st_wt16(base + (long)dvr * 2048 + ch * 8, v);
  }
}

DI bf16x8 packstep(const f32x16& x, int s) {
  uint4 w;
  w.x = cvtpk(x[8 * s], x[8 * s + 1]); w.y = cvtpk(x[8 * s + 2], x[8 * s + 3]);
  w.z = cvtpk(x[8 * s + 4], x[8 * s + 5]); w.w = cvtpk(x[8 * s + 6], x[8 * s + 7]);
  return __builtin_bit_cast(bf16x8, w);
}

template <int DQK, bool MASKED>
DI void attn_compute(const char* bs, const bf16x8 (&qf)[DQK / 16], f32x16 (&O)[2], f32x16& lsumv, const f32x16& nsh16, float nshift,
                     unsigned mwx, unsigned mwy, int lr, int lh) {
  constexpr int KS = DQK * 2 + 16, NS = DQK / 16, VS = 136;
  f32x16 st[2];
#pragma unroll
  for (int i = 0; i < 2; ++i) {
    if (MASKED) {
      const unsigned wsh = (i == 0 ? mwx : mwy) >> (4 * lh);
#pragma unroll
      for (int r = 0; r < 16; ++r) {
        const unsigned m = (unsigned)__builtin_amdgcn_sbfe((int)wsh, (r & 3) + 8 * (r >> 2), 1);
        st[i][r] = __uint_as_float((m & __float_as_uint(nshift)) | (~m & 0xC61C4000u));
      }
    }
#pragma unroll
    for (int s = 0; s < NS; ++s) {
      const bf16x8 kf = *(const bf16x8*)(bs + (32 * i + lr) * KS + s * 32 + lh * 16);
      st[i] = mfma32(kf, qf[s], (!MASKED && s == 0) ? nsh16 : st[i]);
    }
  }
#pragma unroll
  for (int i = 0; i < 2; ++i) {
#pragma unroll
    for (int r = 0; r < 16; ++r) st[i][r] = __builtin_amdgcn_exp2f(st[i][r]);
    lsumv += st[i];
  }
#pragma unroll
  for (int i = 0; i < 2; ++i)
#pragma unroll
    for (int s2 = 0; s2 < 2; ++s2) {
      const bf16x8 pf = packstep(st[i], s2);
#pragma unroll
      for (int j = 0; j < 2; ++j) {
        const char* vp = bs + 13312 + (32 * j + lr) * VS + (32 * i + 16 * s2 + 4 * lh) * 2;
        const s16x4 v0 = *(const s16x4*)(vp);
        const s16x4 v1 = *(const s16x4*)(vp + 16);
        const bf16x8 vf = __builtin_shufflevector(v0, v1, 0, 1, 2, 3, 4, 5, 6, 7);
        O[j] = mfma32(vf, pf, O[j]);
      }
    }
}

template <int DQK, bool MASKED>
DI void attn_item(const Params& p, char* smem, int bidx, int h, int qt, const u16* vTb) {
  constexpr int KS = DQK * 2 + 16;
  constexpr int NS = DQK / 16;
  constexpr int KCH = DQK / 8;
  constexpr int VS = 136;
  constexpr int BUF = 22016;
  const int t = otid(), l = t & 63, w = t >> 6, lr = l & 31, lh = l >> 5;
  const int bh = bidx * 16 + h;
  const int q0 = qt * 256;
  const int nkt = 4 * qt + 4;
  const int nkt_w = 4 * qt + (w >> 1) + 1;
  const u16* Kg = p.kreg() + (long)bh * 2048 * DQK;
  const u16* Qg = p.qreg() + ((long)bh * 2048 + q0 + 32 * w + lr) * DQK + 8 * lh;
  bf16x8 qf[NS];
#pragma unroll
  for (int s = 0; s < NS; ++s) qf[s] = *(const bf16x8*)(Qg + 16 * s);
  const unsigned* mrow = p.mask() + ((long)(bidx * 2048 + q0 + 32 * w + lr)) * 64;

  f32x16 O[2];
#pragma unroll
  for (int j = 0; j < 2; ++j)
#pragma unroll
    for (int r = 0; r < 16; ++r) O[j][r] = 0.f;
  f32x16 lsumv;
#pragma unroll
  for (int r = 0; r < 16; ++r) lsumv[r] = 0.f;
  float nshift;
  {
    const float* gq = MASKED ? p.b_q_norm : p.c_q_norm;
    const float* gk = MASKED ? p.b_k_norm : p.c_k_norm;
    float mq = fabsf(gq[l]), mk = fabsf(gk[l]);
    if (DQK > 64 && l + 64 < DQK) { mq = fmaxf(mq, fabsf(gq[l + 64])); mk = fmaxf(mk, fabsf(gk[l + 64])); }
#pragma unroll
    for (int m = 1; m < 64; m <<= 1) { mq = fmaxf(mq, shx(mq, m)); mk = fmaxf(mk, shx(mk, m)); }
    const float sq = (DQK == 64) ? 8.f : 9.797958971132712f;
    nshift = -fminf(sq * mq * mk * LOG2E_, 60.f);
  }
  f32x16 nsh16;
#pragma unroll
  for (int r = 0; r < 16; ++r) nsh16[r] = nshift;

  const int kr0 = t / KCH, kc0 = t - kr0 * KCH;
  const int c1 = t + 512, kr1 = c1 / KCH, kc1 = c1 - kr1 * KCH;
  const bool has1 = (DQK > 64) && (c1 < 64 * KCH);
  const u16* kg0 = Kg + (long)kr0 * DQK + kc0 * 8;
  const u16* kg1 = Kg + (long)(has1 ? kr1 : 0) * DQK + (has1 ? kc1 : 0) * 8;
  const u16* vg = vTb + (long)(t >> 3) * 2048 + (t & 7) * 8;
  const int kw0 = kr0 * KS + kc0 * 16, kw1 = kr1 * KS + kc1 * 16, vw = 13312 + (t >> 3) * VS + (t & 7) * 16;
  uint4 ka0, ka1, va, kb0, kb1, vb_;
#define ALOAD(K0, K1, V, kt)                                               \
  {                                                                        \
    K0 = *(const uint4*)(kg0 + (long)(kt) * 64 * DQK);                     \
    if (DQK > 64) K1 = *(const uint4*)(kg1 + (long)(kt) * 64 * DQK);       \
    V = *(const uint4*)(vg + (kt) * 64);                                   \
  }
#define AWRITE(K0, K1, V, buf)                                             \
  {                                                                        \
    char* bs_ = smem + (buf) * BUF;                                        \
    *(uint4*)(bs_ + kw0) = K0;                                             \
    if (has1) *(uint4*)(bs_ + kw1) = K1;                                   \
    *(uint2*)(bs_ + vw) = make_uint2(V.x, V.y);                            \
    *(uint2*)(bs_ + vw + 8) = make_uint2(V.z, V.w);                        \
  }
  ALOAD(ka0, ka1, va, 0);
  ALOAD(kb0, kb1, vb_, 1);
  uint4 mwc = make_uint4(0u, 0u, 0u, 0u), mwn = mwc;
  if (MASKED) mwc = *(const uint4*)(mrow);
  AWRITE(ka0, ka1, va, 0);
  __syncthreads();
  for (int kt = 0; kt < nkt; kt += 2) {
    const int k2 = min(kt + 2, nkt - 1), k3 = min(kt + 3, nkt - 1);
    ALOAD(ka0, ka1, va, k2);
    if (MASKED) mwn = *(const uint4*)(mrow + 2 * (kt + 2));
    __builtin_amdgcn_sched_barrier(0);
    if (kt < nkt_w) attn_compute<DQK, MASKED>(smem, qf, O, lsumv, nsh16, nshift, mwc.x, mwc.y, lr, lh);
    __builtin_amdgcn_sched_barrier(0);
    AWRITE(kb0, kb1, vb_, 1);
    __syncthreads();
    ALOAD(kb0, kb1, vb_, k3);
    __builtin_amdgcn_sched_barrier(0);
    if (kt + 1 < nkt_w) attn_compute<DQK, MASKED>(smem + BUF, qf, O, lsumv, nsh16, nshift, mwc.z, mwc.w, lr, lh);
    __builtin_amdgcn_sched_barrier(0);
    AWRITE(ka0, ka1, va, 0);
    __syncthreads();
    mwc = mwn;
  }
#undef ALOAD
#undef AWRITE
  float lsum = 0.f;
#pragma unroll
  for (int r = 0; r < 16; ++r) lsum += lsumv[r];
  lsum += shx(lsum, 32);
  const float inv = 1.f / lsum;
  {
    float* slab = (float*)(smem + 45056 + w * 8704);
#pragma unroll
    for (int j = 0; j < 2; ++j)
#pragma unroll
      for (int g4 = 0; g4 < 4; ++g4)
        *(float4*)(slab + lr * 68 + 32 * j + 8 * g4 + 4 * lh) =
            make_float4(O[j][4 * g4] * inv, O[j][4 * g4 + 1] * inv, O[j][4 * g4 + 2] * inv, O[j][4 * g4 + 3] * inv);
    __builtin_amdgcn_fence(__ATOMIC_RELEASE, "wavefront");
    __builtin_amdgcn_wave_barrier();
    __builtin_amdgcn_fence(__ATOMIC_ACQUIRE, "wavefront");
    const int rr = l >> 3, ch = l & 7;
#pragma unroll
    for (int it = 0; it < 4; ++it) {
      const int row = rr + 8 * it;
      const long o = ((long)(bidx * 2048 + q0 + 32 * w + row)) * 1024 + h * 64 + ch * 8;
      const uint4 z = *(const uint4*)(p.szb() + o);
      const float4 a = *(const float4*)(slab + row * 68 + ch * 8), b = *(const float4*)(slab + row * 68 + ch * 8 + 4);
      uint4 ov;
      ov.x = cvtpk(a.x * bflo(z.x), a.y * bfhi(z.x)); ov.y = cvtpk(a.z * bflo(z.y), a.w * bfhi(z.y));
      ov.z = cvtpk(b.x * bflo(z.z), b.y * bfhi(z.z)); ov.w = cvtpk(b.z * bflo(z.w), b.w * bfhi(z.w));
      st_wt16(p.vb() + o, ov);
    }
  }
}

DI unsigned fkey(float x) {
  if (x == 0.f) x = 0.f;
  const unsigned u = __float_as_uint(x);
  return (u & 0x80000000u) ? ~u : (u | 0x80000000u);
}

template <int R>
DI void idx_select(char* simg, unsigned* mbase, int l, int w) {
  const int j = l & 31, myq = 2 * w + (l >> 5);
  unsigned k2[R];
  {
    const char* src = simg + myq * 8720 + ((R * j) >> 6) * 272 + ((R * j) & 63) * 4;
#pragma unroll
    for (int i = 0; i < R / 4; ++i) { const uint4 v = *(const uint4*)(src + 16 * i); k2[4 * i] = v.x; k2[4 * i + 1] = v.y; k2[4 * i + 2] = v.z; k2[4 * i + 3] = v.w; }
  }
  __syncthreads();
#define DPPU(v, ctl) ((unsigned)__builtin_amdgcn_update_dpp(0, (int)(v), ctl, 0xF, 0xF, true))
#define HALF_SUM(v) { v += DPPU(v, 0xB1); v += DPPU(v, 0x4E); v += DPPU(v, 0x124); v += DPPU(v, 0x128); v += shxu(v, 16); }
  unsigned tq = 0u;
  bool done = false;
  for (int bit = 31; bit >= 0; --bit) {
    const unsigned cand = tq | (1u << bit);
    unsigned cnt = 0u;
    unsigned cntb = 0u;
#pragma unroll
    for (int e = 0; e < R; e += 2) {
      unsigned long long sp;
      asm volatile("v_cmp_ge_u32_e64 %2, %3, %5\n\tv_cmp_ge_u32_e32 vcc, %4, %5\n\tv_addc_co_u32_e64 %0, %2, 0, %0, %2\n\tv_addc_co_u32_e32 %1, vcc, 0, %1, vcc"
                   : "+v"(cnt), "+v"(cntb), "=&s"(sp) : "v"(k2[e]), "v"(k2[e + 1]), "v"(cand) : "vcc");
    }
    cnt += cntb;
    HALF_SUM(cnt);
    if (!done && cnt >= 256u) { tq = cand; if (cnt == 256u) done = true; }
    if (__all(done ? 1 : 0)) break;
  }
  unsigned thr_gt = tq - 1u;
  int J0 = -1;
  const bool wavetie = !__all(done ? 1 : 0);
  const int laneoff = R * j;
  if (wavetie) {
    unsigned cgt = 0u;
#pragma unroll
    for (int e = 0; e < R; ++e)
      asm volatile("v_cmp_gt_u32_e32 vcc, %1, %2\n\tv_addc_co_u32_e32 %0, vcc, 0, %0, vcc" : "+v"(cgt) : "v"(k2[e]), "v"(tq) : "vcc");
    HALF_SUM(cgt);
    const unsigned need = 256u - cgt;
    const int vbig = (int)0x80000000;
    int J = 0;
    for (int bit = 10; bit >= 0; --bit) {
      const int candJ = J | (1 << bit);
      unsigned c2 = 0u;
#pragma unroll
      for (int e = 0; e < R; ++e) {
        unsigned tmp;
        asm volatile("v_cmp_eq_u32_e32 vcc, %2, %3\n\tv_cndmask_b32_e32 %1, %4, %5, vcc\n\tv_cmp_lt_i32_e32 vcc, %6, %1\n\tv_addc_co_u32_e32 %0, vcc, 0, %0, vcc"
                     : "+v"(c2), "=&v"(tmp) : "v"(k2[e]), "v"(tq), "v"(vbig), "v"(candJ - laneoff), "i"(e) : "vcc");
      }
      HALF_SUM(c2);
      if (c2 < need) J = candJ;
    }
    if (!done) { thr_gt = tq; J0 = J; }
  }
#undef HALF_SUM
#undef DPPU
  const int J0l = J0 - laneoff;
  const int vbig2 = (int)0x80000000;
  const unsigned allones = 0xFFFFFFFFu;
  unsigned wd[R / 32];
#pragma unroll
  for (int wi = 0; wi < R / 32; ++wi) {
    unsigned nb = 0u;
#pragma unroll
    for (int e = 31; e >= 0; --e) {
      unsigned k = k2[32 * wi + e];
      if (wavetie) {
        unsigned tmp;
        asm volatile("v_cmp_eq_u32_e32 vcc, %1, %2\n\tv_cndmask_b32_e32 %0, %3, %4, vcc\n\tv_cmp_le_i32_e32 vcc, %6, %0\n\tv_cndmask_b32_e32 %0, %1, %5, vcc"
                     : "=&v"(tmp) : "v"(k), "v"(tq), "v"(vbig2), "v"(J0l), "v"(allones), "i"(32 * wi + e) : "vcc");
        k = tmp;
      }
      asm volatile("v_cmp_gt_u32_e32 vcc, %1, %2\n\tv_addc_co_u32_e32 %0, vcc, %0, %0, vcc" : "+v"(nb) : "v"(k), "v"(thr_gt) : "vcc");
    }
    wd[wi] = nb;
  }
  if (R == 64) *(uint2*)(mbase + myq * 64 + 2 * j) = make_uint2(wd[0], wd[R / 32 - 1]);
  else { mbase[myq * 64 + j] = wd[0]; mbase[myq * 64 + 32 + j] = 0u; }
}

DI void idx_item(const Params& p, char* smem, int bidx, int c, int qq) {
  const int t = otid(), l = t & 63, w = t >> 6, lq = l & 15, lg = l >> 4;
  const int q0 = c * 64 + qq * 16;
  unsigned* mbase = p.mask() + ((long)(bidx * 2048 + q0)) * 64;
  if (c <= 3) {
#pragma unroll
    for (int i = 0; i < 2; ++i) {
      const int idx = t + 512 * i, q = idx >> 6, wd = idx & 63;
      mbase[q * 64 + wd] = (wd < 2 * (c + 1)) ? 0xFFFFFFFFu : 0u;
    }
    return;
  }
  const int ngroups = 2 * (c + 1);
  const int ng = (ngroups - w + 7) >> 3;
  float wv[8];
  {
    const float* wp = p.wif() + (long)(bidx * 2048 + q0 + lq) * 8;
    const float4 a = *(const float4*)wp, b = *(const float4*)(wp + 4);
    wv[0] = a.x; wv[1] = a.y; wv[2] = a.z; wv[3] = a.w; wv[4] = b.x; wv[5] = b.y; wv[6] = b.z; wv[7] = b.w;
  }
  unsigned kx[8][2][4];
  const u16* kp = p.kib() + ((long)(bidx * 2048) + lq) * 64 + 8 * lg;
  bf16x8 af[8][2][2];
#pragma unroll
  for (int gi = 0; gi < 8; ++gi)
#pragma unroll
    for (int sub = 0; sub < 2; ++sub) {
      const int key0 = (w + 8 * gi) * 32 + sub * 16;
      af[gi][sub][0] = *(const bf16x8*)(kp + (long)key0 * 64);
      af[gi][sub][1] = *(const bf16x8*)(kp + (long)key0 * 64 + 32);
    }
  bf16x8* qfl = (bf16x8*)(smem + 2048);
  {
    const u16* qp = p.qib() + ((long)(bidx * 2048 + q0 + lq) * 8) * 64 + 8 * lg;
#pragma unroll
    for (int i = 0; i < 2; ++i) { const int hk = w * 2 + i; qfl[hk * 64 + l] = *(const bf16x8*)(qp + (hk >> 1) * 64 + (hk & 1) * 32); }
  }
  __syncthreads();
  __builtin_amdgcn_sched_barrier(0);
#pragma unroll
  for (int gi = 0; gi < 8; ++gi) {
    if (gi < ng) {
#pragma unroll
      for (int sub = 0; sub < 2; ++sub) {
        int qo = l;
        asm volatile("" : "+v"(qo));
        f32x4 sc = {0.f, 0.f, 0.f, 0.f};
#pragma unroll
        for (int h = 0; h < 8; ++h) {
          f32x4 acc = {0.f, 0.f, 0.f, 0.f};
          acc = mfma16(af[gi][sub][0], qfl[(2 * h) * 64 + qo], acc);
          acc = mfma16(af[gi][sub][1], qfl[(2 * h + 1) * 64 + qo], acc);
#pragma unroll
          for (int r = 0; r < 4; ++r) sc[r] += wv[h] * fmaxf(acc[r], 0.f);
        }
#pragma unroll
        for (int r = 0; r < 4; ++r) kx[gi][sub][r] = fkey(sc[r]);
      }
    } else {
#pragma unroll
      for (int sub = 0; sub < 2; ++sub)
#pragma unroll
        for (int r = 0; r < 4; ++r) kx[gi][sub][r] = 0u;
    }
  }
  char* simg = smem + 18432;
#pragma unroll
  for (int gi = 0; gi < 8; ++gi)
#pragma unroll
    for (int sub = 0; sub < 2; ++sub) {
      const int key0 = (w + 8 * gi) * 32 + sub * 16 + 4 * lg;
      *(uint4*)(simg + lq * 8720 + (key0 >> 6) * 272 + (key0 & 63) * 4) = make_uint4(kx[gi][sub][0], kx[gi][sub][1], kx[gi][sub][2], kx[gi][sub][3]);
    }
  __syncthreads();
  if (c <= 15) idx_select<32>(simg, mbase, l, w);
  else idx_select<64>(simg, mbase, l, w);
}

#define XB_TMO      128
#define XB_XCNT(j)  (256  + 64 * (j))
#define XB_XSUB(j)  (1280 + 64 * (j))
#define XB_XGEN(j)  (2304 + 64 * (j))
#define XB_TOP      3328
#define XB_TOPGEN   3392
#define XCD_BAR_WORDS 3456
#define XB_SPIN_CAP (1u << 20)
#define LAS __attribute__((address_space(3)))
DI unsigned xb_ld(unsigned* p) { return __hip_atomic_load(p, __ATOMIC_RELAXED, __HIP_MEMORY_SCOPE_AGENT); }
DI unsigned xb_add(unsigned* p, unsigned v) { return __hip_atomic_fetch_add(p, v, __ATOMIC_RELAXED, __HIP_MEMORY_SCOPE_AGENT); }
DI unsigned xb_xcc_id() { return (unsigned)__builtin_amdgcn_s_getreg((3 << 11) | 20) & 0xFu; }
#define XB_SPIN(cond, bar) do { unsigned _sp = 0; while (cond) { __builtin_amdgcn_s_sleep(1); \
    if ((++_sp & 255u) == 0u) { if (xb_ld(&(bar)[XB_TMO])) break; if (_sp > XB_SPIN_CAP) { atomicAdd(&(bar)[XB_TMO], 1u); break; } } } } while (0)
struct XcdBarrier { unsigned* bar; unsigned x; volatile LAS unsigned* st; };
DI XcdBarrier xcd_barrier_post(unsigned* bar, volatile LAS unsigned* st) {
  XcdBarrier b; b.bar = bar; b.x = xb_xcc_id(); b.st = st;
  if (threadIdx.x == 0) (void)xb_add(&bar[XB_XCNT(b.x)], 1u);
  return b;
}
DI void xcd_barrier_complete(unsigned* bar, unsigned x, unsigned& nloc, unsigned& nx) {
  const unsigned G = gridDim.x * gridDim.y * gridDim.z;
  unsigned sum, cnt, mine, sp = 0u;
  for (;;) {
    sum = 0u; cnt = 0u; mine = 0u;
#pragma unroll
    for (unsigned j = 0; j < 16; ++j) { const unsigned c = xb_ld(&bar[XB_XCNT(j)]); sum += c; cnt += (c > 0u) ? 1u : 0u; mine = (j == x) ? c : mine; }
    if (sum == G) break;
    __builtin_amdgcn_s_sleep(1);
    if ((++sp & 255u) == 0u) { if (xb_ld(&bar[XB_TMO])) break; if (sp > XB_SPIN_CAP) { atomicAdd(&bar[XB_TMO], 1u); break; } }
  }
  nloc = mine > 0u ? mine : 1u; nx = cnt > 0u ? cnt : 1u;
}
DI void xcd_barrier(const XcdBarrier& b) {
  asm volatile("s_waitcnt vmcnt(0)" ::: "memory");
  __syncthreads();
  if (threadIdx.x == 0) {
    unsigned* bar = b.bar;
    __builtin_amdgcn_s_waitcnt(0);
    unsigned nloc = b.st[0], nx = b.st[1];
    if (nloc == 0u) { xcd_barrier_complete(bar, b.x, nloc, nx); b.st[0] = nloc; b.st[1] = nx; }
    const unsigned old = xb_add(&bar[XB_XSUB(b.x)], 1u);
    const unsigned gen = old / nloc;
    if (old + 1u == (gen + 1u) * nloc) {
      __builtin_amdgcn_fence(__ATOMIC_RELEASE, "agent");
      asm volatile("s_waitcnt vmcnt(0)" ::: "memory");
      const unsigned og = xb_add(&bar[XB_TOP], 1u);
      const unsigned tg = og / nx;
      if (og + 1u == (tg + 1u) * nx) xb_add(&bar[XB_TOPGEN], 1u);
      else XB_SPIN(xb_ld(&bar[XB_TOPGEN]) == tg, bar);
      __builtin_amdgcn_fence(__ATOMIC_ACQUIRE, "agent");
      asm volatile("s_waitcnt vmcnt(0)" ::: "memory");
    } else {
      XB_SPIN(xb_ld(&bar[XB_TOPGEN]) == gen, bar);
      __builtin_amdgcn_fence(__ATOMIC_ACQUIRE, "agent");
      asm volatile("s_waitcnt vmcnt(0)" ::: "memory");
    }
  }
  __syncthreads();
}

DI int fetch_item(const Params& p, char* smem, int which) {
  int* si = (int*)(smem + LDS_ITEM);
  __syncthreads();
  if (threadIdx.x == 0) *si = (int)atomicAdd(&p.counters()[which], 1u);
  __syncthreads();
  return *si;
}

DI void tile_pm_pn(int id, int nM, int nN, int& pm, int& pn) {
  const int nig = 8 * nN, gid = id / nig, fm = gid * 8, gsz = min(nM - fm, 8);
  const int r = id - gid * nig;
  pm = fm + (r % gsz); pn = r / gsz;
}
DI int tile_of(int round, int ntiles) {
  const int b = blockIdx.x, g = gridDim.x;
  const int v = (g % 8 == 0) ? (b & 7) * (g >> 3) + (b >> 3) : b;
  return round * g + v;
}

DI void fill_rs(char* smem, const float* rss, int row0, int rlo, int rhi, float invK) {
  float* rs = (float*)(smem + LDS_RS2);
  const int t = otid();
  if (t < 256) rs[t] = rsqrtf(rss[row0 + t] * invK + EPS_);
}

DI void phase_conv_in(const Params& p, char* smem, int layer) {
  const u16* Wt = layer ? p.WaT1() : p.WaT0();
  const float* rss = p.rss() + (layer ? 3 : 0) * 16384;
  const float* rs0_ = (const float*)(smem + LDS_RS2);
  for (int round = 0; round * (int)gridDim.x < 64 * 16; ++round) {
    const int tile = tile_of(round, 64 * 16);
    if (tile < 64 * 16) {
      int pm, pn; tile_pm_pn(tile, 64, 16, pm, pn);
      acc_t acc;
      gemm256(p.xb(), (long)pm * 256, (long)pm * 256 + 128, Wt, pn * 256, 1024, smem, acc);
      fill_rs(smem, rss, pm * 256, 0, 16384, 1.f / 1024.f);
#pragma unroll
      for (int ai = 0; ai < 2; ++ai) {
        dump_half(acc, ai, smem);
        int tx_ = threadIdx.x; asm volatile("" : "+v"(tx_));
        const int tq = tx_ & 255, hq = tx_ >> 8;
        const float* rs = rs0_ + ai * 128;
        __syncthreads();
        epi_conv(p, smem + hq * LDS_Q, rs, tq, layer, pm * 256 + ai * 128, ai, pm, pn * 2 + hq, (float*)(smem + LDS_UPREV) + hq * 64);
        __syncthreads();
      }
    }
  }
}

DI void phase_out(const Params& p, char* smem, const u16* Wt, float* rss_next, const float* res_in, int conv_layer) {
  const float* rs0_ = (const float*)(smem + LDS_RS2);
  for (int round = 0; round * (int)gridDim.x < 64 * 4; ++round) {
    const int tile = tile_of(round, 64 * 4);
    if (tile < 64 * 4) {
      int pm, pn; tile_pm_pn(tile, 64, 4, pm, pn);
      acc_t acc;
      if (conv_layer >= 0) conv_fixup(p, conv_layer, pm);
      gemm256(p.vb(), (long)pm * 256, (long)pm * 256 + 128, Wt, pn * 256, 1024, smem, acc);
#pragma unroll
      for (int ai = 0; ai < 2; ++ai) {
        dump_half(acc, ai, smem);
        int tx_ = threadIdx.x; asm volatile("" : "+v"(tx_));
        const int tq = tx_ & 255, hq = tx_ >> 8;
        const float* rs = rs0_;
        __syncthreads();
        epi_res(p, smem + hq * LDS_Q, rs, tq, pm * 256 + ai * 128, pn * 256 + hq * 128, rss_next, res_in);
        __syncthreads();
      }
    }
  }
}

DI void phase_bin(const Params& p, char* smem) {
  const float* rs0_ = (const float*)(smem + LDS_RS2);
  for (int round = 0; round * (int)gridDim.x < 64 * 19; ++round) {
    const int tile = tile_of(round, 64 * 19);
    if (tile < 64 * 19) {
      int pm, pn; tile_pm_pn(tile, 64, 19, pm, pn);
      acc_t acc;
      gemm256(p.xb(), (long)pm * 256, (long)pm * 256 + 128, p.WbT(), pn * 256, 1024, smem, acc);
      fill_rs(smem, p.rss() + 16384, pm * 256, 0, 16384, 1.f / 1024.f);
#pragma unroll
      for (int ai = 0; ai < 2; ++ai) {
        dump_half(acc, ai, smem);
        int tx_ = threadIdx.x; asm volatile("" : "+v"(tx_));
        const int tq = tx_ & 255, hq = tx_ >> 8;
        const float* rs = rs0_ + ai * 128;
        __syncthreads();
        VReg vr;
#pragma unroll
        for (int i_ = 0; i_ < 8; ++i_) vr.v[i_] = make_uint4(0u, 0u, 0u, 0u);
        epi_bin(p, smem + hq * LDS_Q, rs, tq, pm * 256 + ai * 128, pn * 2 + hq, vr);
        __syncthreads();
        copy_bin(p, smem + hq * LDS_Q, tq, pm * 256 + ai * 128, pn * 2 + hq, vr);
        __syncthreads();
        copy2_bin(p, smem + hq * LDS_Q, tq, pm * 256 + ai * 128, pn * 2 + hq);
        __syncthreads();
      }
    }
  }
}

DI void phase_cin(const Params& p, char* smem) {
  const float* rs0_ = (const float*)(smem + LDS_RS2);
  for (int round = 0; round * (int)gridDim.x < 64 * 7; ++round) {
    const int tile = tile_of(round, 64 * 7);
    if (tile < 64 * 7) {
      int pm, pn; tile_pm_pn(tile, 64, 7, pm, pn);
      acc_t acc;
      gemm256(p.xb(), (long)pm * 256, (long)pm * 256 + 128, p.WcT(), pn * 256, 1024, smem, acc);
      fill_rs(smem, p.rss() + 2 * 16384, pm * 256, 0, 16384, 1.f / 1024.f);
#pragma unroll
      for (int ai = 0; ai < 2; ++ai) {
        dump_half(acc, ai, smem);
        int tx_ = threadIdx.x; asm volatile("" : "+v"(tx_));
        const int tq = tx_ & 255, hq = tx_ >> 8;
        const float* rs = rs0_ + ai * 128;
        __syncthreads();
        epi_cin(p, smem + hq * LDS_Q, rs, tq, pm * 256 + ai * 128, pn * 2 + hq);
        __syncthreads();
      }
    }
  }
}

DI void phase_up(const Params& p, char* smem) {
  const float* rs0_ = (const float*)(smem + LDS_RS2);
  for (int round = 0; round * (int)gridDim.x < 1024; ++round) {
    const int tile = tile_of(round, 1024);
    if (tile < 1024) {
      const int which = tile >> 9;
      int pm, pn; tile_pm_pn(tile & 511, 64, 8, pm, pn);
      acc_t acc;
      if (which == 0) gemm256(p.cqb(), (long)pm * 256, (long)pm * 256 + 128, p.WuqT(), pn * 256, 384, smem, acc);
      else gemm256(p.ckvb(), (long)pm * 256, (long)pm * 256 + 128, p.WukvT(), pn * 256, 256, smem, acc);
      if (which == 0) fill_rs(smem, p.rss() + 4 * 16384, pm * 256, 0, 16384, 1.f / 384.f);
      else fill_rs(smem, p.rss() + 5 * 16384, pm * 256, 0, 16384, 1.f / 256.f);
#pragma unroll
      for (int ai = 0; ai < 2; ++ai) {
        dump_half(acc, ai, smem);
        int tx_ = threadIdx.x; asm volatile("" : "+v"(tx_));
        const int tq = tx_ & 255, hq = tx_ >> 8;
        const float* rs = rs0_ + ai * 128;
        __syncthreads();
        VReg vr;
#pragma unroll
        for (int i_ = 0; i_ < 8; ++i_) vr.v[i_] = make_uint4(0u, 0u, 0u, 0u);
        if (which == 0) epi_uq(p, smem + hq * LDS_Q, rs, tq, pm * 256 + ai * 128, pn * 2 + hq);
        else epi_ukv(p, smem + hq * LDS_Q, rs, tq, pm * 256 + ai * 128, pn * 2 + hq, vr);
        __syncthreads();
        if (which == 0) copy_uq(p, smem + hq * LDS_Q, tq, pm * 256 + ai * 128, pn * 2 + hq);
        else copy_ukv(p, smem + hq * LDS_Q, tq, pm * 256 + ai * 128, pn * 2 + hq, vr);
        __syncthreads();
        if (which != 0) copy2_ukv(p, smem + hq * LDS_Q, tq, pm * 256 + ai * 128, pn * 2 + hq);
        __syncthreads();
      }
    }
  }
}

DI void phase_idx(const Params& p, char* smem, int counter) {
  int* si = (int*)(smem + LDS_ITEM);
  int it = fetch_item(p, smem, counter);
  while (it < 1024) {
    unsigned nxt = 0u;
    if (threadIdx.x == 0) nxt = atomicAdd(&p.counters()[counter], 1u);
    const int c = 31 - (it >> 5), r = it & 31;
    idx_item(p, smem, r >> 2, c, r & 3);
    __syncthreads();
    if (threadIdx.x == 0) *si = (int)nxt;
    __syncthreads();
    it = *si;
  }
}

template <int DQK, bool MASKED>
DI void phase_attn(const Params& p, char* smem, int counter) {
  int* si = (int*)(smem + LDS_ITEM);
  int it = fetch_item(p, smem, counter);
  while (it < 1024) {
    unsigned nxt = 0u;
    if (threadIdx.x == 0) nxt = atomicAdd(&p.counters()[counter], 1u);
    const int qt = 7 - (it >> 7), bh = it & 127;
    const u16* vTb = MASKED ? vT1_ptr(p, bh) : ((const u16*)p.out + (long)bh * 131072);
    attn_item<DQK, MASKED>(p, smem, bh >> 4, bh & 15, qt, vTb);
    __syncthreads();
    if (threadIdx.x == 0) *si = (int)nxt;
    __syncthreads();
    it = *si;
  }
}

__global__ void __launch_bounds__(512, 2) mega_kernel(Params p, int ph_lo, int ph_hi) {
  __shared__ __attribute__((aligned(16))) char smem[LDS_TOTAL];
  cg::grid_group grid = cg::this_grid();
  __shared__ uint4 xb_words;
  if (threadIdx.x == 0) xb_words = make_uint4(0u, 0u, 0u, 0u);
  __syncthreads();
  const XcdBarrier xbar = xcd_barrier_post(p.bar(), (volatile LAS unsigned*)&xb_words);
  if (ph_hi > 1000) grid.sync();
#ifndef ONLYP
#define ONLYP -1
#endif
#define PHON(n) (ONLYP < 0 || ONLYP == (n))
#ifndef REPMASK
#define REPMASK 0
#endif
#define RUNPH(n, gate, call)                                                  \
  if (ph_lo <= (n) && (n) < ph_hi) {                                          \
    for (int rep = 0; rep < 1 + ((REPMASK >> (n)) & 1); ++rep) {              \
      if (PHON(gate)) { call; }                                               \
      if ((n) + 1 < ph_hi) xcd_barrier(xbar);                                 \
    }                                                                         \
  }
  RUNPH(0, 0, phase_prep(p, smem))
  RUNPH(1, 1, phase_conv_in(p, smem, 0))
  RUNPH(2, 2, phase_out(p, smem, p.WaoT0(), p.rss() + 16384, p.x, 0))
  RUNPH(3, 3, phase_bin(p, smem))
  RUNPH(4, 4, phase_idx(p, smem, 0 + 4 * rep))
  RUNPH(5, 5, (phase_attn<64, true>(p, smem, 1 + 4 * rep)))
  RUNPH(6, 2, phase_out(p, smem, p.WboT(), p.rss() + 2 * 16384, p.out, -1))
  RUNPH(7, 7, phase_cin(p, smem))
  RUNPH(8, 8, phase_up(p, smem))
  RUNPH(9, 9, (phase_attn<96, false>(p, smem, 2 + 4 * rep)))
  RUNPH(10, 2, phase_out(p, smem, p.WcoT(), p.rss() + 3 * 16384, p.out, -1))
  RUNPH(11, 1, phase_conv_in(p, smem, 1))
  RUNPH(12, 2, phase_out(p, smem, p.WaoT1(), nullptr, nullptr, 1))
}

extern "C" void kernel_launch(void* const* d_in, const int* in_sizes, int n_in, void* d_out, int out_size, void* d_ws,
                              size_t ws_size, hipStream_t stream) {
  static int grid_blocks = 0;
  if (!grid_blocks) {
    int dev = 0, cus = 0, per_cu = 0;
    hipGetDevice(&dev);
    hipDeviceGetAttribute(&cus, hipDeviceAttributeMultiprocessorCount, dev);
    hipOccupancyMaxActiveBlocksPerMultiprocessor(&per_cu, mega_kernel, 512, 0);
    if (per_cu > 1) per_cu = 1;
    if (per_cu < 1) per_cu = 1;
    grid_blocks = cus * per_cu;
  }
  const size_t need = 265703424ull;
  if (ws_size < need) { fprintf(stderr, "workspace too small: %zu < %zu\n", ws_size, need); return; }
  Params p{};
  p.x = (const float*)d_in[0]; p.pos = (const int*)d_in[1];
  p.a_norm = (const float*)d_in[2]; p.a_w_in = (const float*)d_in[3]; p.a_conv_w = (const float*)d_in[4];
  p.a_conv_b = (const float*)d_in[5]; p.a_w_out = (const float*)d_in[6];
  p.b_norm = (const float*)d_in[7]; p.b_w_in = (const float*)d_in[8]; p.b_q_norm = (const float*)d_in[9];
  p.b_k_norm = (const float*)d_in[10]; p.b_w_out = (const float*)d_in[11];
  p.c_norm = (const float*)d_in[12]; p.c_w_in = (const float*)d_in[13]; p.c_q_lat_norm = (const float*)d_in[14];
  p.c_kv_lat_norm = (const float*)d_in[15]; p.c_w_uq = (const float*)d_in[16]; p.c_w_ukv = (const float*)d_in[17];
  p.c_q_norm = (const float*)d_in[18]; p.c_k_norm = (const float*)d_in[19]; p.c_w_out = (const float*)d_in[20];
  p.out = (float*)d_out;
  p.ws = (char*)d_ws;
  hipMemsetAsync(p.ws + 263716864, 0, 4096 + 16384, stream);
  int lo = 0, hi = 13;
  void* args[] = {&p, &lo, &hi};
  hipError_t e = hipLaunchCooperativeKernel((void*)mega_kernel, dim3(grid_blocks), dim3(512), args, 0, stream);
  if (e != hipSuccess) fprintf(stderr, "cooperative launch failed: %s (grid %d)\n", hipGetErrorString(e), grid_blocks);
}
```

```cpp
#include <hip/hip_runtime.h>
#include <hip/hip_cooperative_groups.h>
#include <stdint.h>
#include <stdio.h>
namespace cg = cooperative_groups;

#define DI __device__ __forceinline__

typedef unsigned short u16;
using bf16x8 = __attribute__((ext_vector_type(8))) short;
using s16x4 = __attribute__((ext_vector_type(4))) short;
using f32x16 = __attribute__((ext_vector_type(16))) float;
using f32x4 = __attribute__((ext_vector_type(4))) float;
using f32x2 = __attribute__((ext_vector_type(2))) float;
using bf16x2v = __attribute__((ext_vector_type(2))) __bf16;
using u32x4v = __attribute__((ext_vector_type(4))) unsigned;
using u32x2v = __attribute__((ext_vector_type(2))) unsigned;

constexpr float EPS_ = 1e-6f;
constexpr float LOG2E_ = 1.4426950408889634f;

__device__ const float c_inv[32] = {
    1.000000000e+00f, 7.498942614e-01f, 5.623413324e-01f, 4.216965139e-01f, 3.162277639e-01f, 2.371373773e-01f,
    1.778279394e-01f, 1.333521307e-01f, 1.000000015e-01f, 7.498941571e-02f, 5.623413250e-02f, 4.216965288e-02f,
    3.162277490e-02f, 2.371373773e-02f, 1.778279431e-02f, 1.333521493e-02f, 9.999999776e-03f, 7.498941850e-03f,
    5.623413250e-03f, 4.216964822e-03f, 3.162277630e-03f, 2.371373586e-03f, 1.778279431e-03f, 1.333521446e-03f,
    1.000000047e-03f, 7.498942432e-04f, 5.623413017e-04f, 4.216965172e-04f, 3.162277571e-04f, 2.371373703e-04f,
    1.778279402e-04f, 1.333521504e-04f};

struct Params {
  const float* x; const int* pos;
  const float *a_norm, *a_w_in, *a_conv_w, *a_conv_b, *a_w_out;
  const float *b_norm, *b_w_in, *b_q_norm, *b_k_norm, *b_w_out;
  const float *c_norm, *c_w_in, *c_q_lat_norm, *c_kv_lat_norm, *c_w_uq, *c_w_ukv, *c_q_norm, *c_k_norm, *c_w_out;
  float* out;
  char* ws;
  DI u16* WaT0() const { return (u16*)(ws + 0l); }
  DI u16* WaoT0() const { return (u16*)(ws + 8388608l); }
  DI u16* WaT1() const { return (u16*)(ws + 10485760l); }
  DI u16* WaoT1() const { return (u16*)(ws + 18874368l); }
  DI u16* WbT() const { return (u16*)(ws + 20971520l); }
  DI u16* WboT() const { return (u16*)(ws + 30932992l); }
  DI u16* WcT() const { return (u16*)(ws + 33030144l); }
  DI u16* WuqT() const { return (u16*)(ws + 36700160l); }
  DI u16* WukvT() const { return (u16*)(ws + 38273024l); }
  DI u16* WcoT() const { return (u16*)(ws + 39321600l); }
  DI u16* xb() const { return (u16*)(ws + 41418752l); }
  DI u16* vb() const { return (u16*)(ws + 74973184l); }
  DI u16* szb() const { return (u16*)(ws + 108527616l); }
  DI u16* qreg() const { return (u16*)(ws + 142082048l); }
  DI u16* kreg() const { return (u16*)(ws + 192413696l); }
  DI u16* qib() const { return (u16*)(ws + 242745344l); }
  DI float2* rope() const { return (float2*)(ws + 259522560l); }
  DI unsigned* counters() const { return (unsigned*)(ws + 263716864l); }
  DI unsigned* bar() const { return (unsigned*)(ws + 263720960l); }
  DI float* rss() const { return (float*)(ws + 263737344l); }
  DI float* convPF() const { return (float*)(ws + 264130560l); }
  DI float* convUF() const { return (float*)(ws + 264654848l); }
  DI float* convUL() const { return (float*)(ws + 265179136l); }
  DI unsigned* mask() const { return (unsigned*)(ws + 0l); }
  DI u16* kib() const { return (u16*)(ws + 4194304l); }
  DI float* wif() const { return (float*)(ws + 6291456l); }
  DI float* krf() const { return (float*)(ws + 8388608l); }
  DI u16* cqb() const { return (u16*)(ws + 74973184l); }
  DI u16* ckvb() const { return (u16*)(ws + 87556096l); }
};

DI unsigned cvtpk(float lo, float hi) { f32x2 v = {lo, hi}; bf16x2v b = __builtin_convertvector(v, bf16x2v); return __builtin_bit_cast(unsigned, b); }
DI float bflo(unsigned w) { return __uint_as_float(w << 16); }
DI float bfhi(unsigned w) { return __uint_as_float(w & 0xFFFF0000u); }
DI float silu_f(float x) { return x / (1.f + __expf(-x)); }
DI f32x16 mfma32(bf16x8 a, bf16x8 b, f32x16 c) { return __builtin_amdgcn_mfma_f32_32x32x16_bf16(a, b, c, 0, 0, 0); }
DI f32x4 mfma16(bf16x8 a, bf16x8 b, f32x4 c) { return __builtin_amdgcn_mfma_f32_16x16x32_bf16(a, b, c, 0, 0, 0); }
DI uint4 pack8(const float* v) { uint4 r; r.x = cvtpk(v[0], v[1]); r.y = cvtpk(v[2], v[3]); r.z = cvtpk(v[4], v[5]); r.w = cvtpk(v[6], v[7]); return r; }
DI int otid() { int t = threadIdx.x; asm volatile("" : "+v"(t)); return t; }
DI float4 ld_nt4(const float* p) { const f32x4 v = __builtin_nontemporal_load((const f32x4*)p); return make_float4(v[0], v[1], v[2], v[3]); }
DI void st_nt4(void* p, uint4 v) { u32x4v w = {v.x, v.y, v.z, v.w}; __builtin_nontemporal_store(w, (u32x4v*)p); }
DI void st_nt2(void* p, uint2 v) { u32x2v w = {v.x, v.y}; __builtin_nontemporal_store(w, (u32x2v*)p); }
DI void st_wt16(void* p, uint4 v) { u32x4v w = {v.x, v.y, v.z, v.w}; asm volatile("global_store_dwordx4 %0, %1, off sc1\n\ts_nop 2" :: "v"(p), "v"(w) : "memory");     }
DI void st_wt8(void* p, uint2 v) { u32x2v w = {v.x, v.y}; asm volatile("global_store_dwordx2 %0, %1, off sc1\n\ts_nop 2" :: "v"(p), "v"(w) : "memory"); }
DI float shx(float v, int m) { return __shfl_xor(v, m, 64); }
DI unsigned shxu(unsigned v, int m) { return (unsigned)__shfl_xor((int)v, m, 64); }

constexpr int LDS_Q = 67584;
constexpr int LDS_RS = 157952;
constexpr int LDS_ITEM = 158464;
constexpr int LDS_UPREV = 158720;
constexpr int LDS_RS2 = 159232;
constexpr int LDS_TOTAL = 160256;
constexpr int CS_LD = 132;
constexpr int NT = 512;

DI int map_col(int kind, int n) {
  switch (kind) {
    case 1: return ((n >> 5) & 3) * 1024 + (n >> 7) * 32 + (n & 31);
    case 2: return n < 640 ? n : (n < 1664 ? n + 32 : (n < 1696 ? n - 1024 : -1));
    case 3: { int d = n & 127; return d < 96 ? (n >> 7) * 96 + d : -1; }
    case 4: return n < 4680 ? n : -1;
    default: return n;
  }
}

struct WJob { const float* W; u16* Wt; const float* gain; int K, Nsrc, ntn, kind, lt; };
DI WJob prep_job(const Params& p, int tile) {
  WJob j;
  int Np, base;
  if (tile < 1024)      { j.W = p.a_w_in; j.Wt = p.WaT0(); j.gain = p.a_norm; j.K = 1024; j.Nsrc = 4096; Np = 4096; j.kind = 1; base = 0; }
  else if (tile < 2048) { j.W = p.a_w_in + 1024 * 4096; j.Wt = p.WaT1(); j.gain = p.a_norm + 1024; j.K = 1024; j.Nsrc = 4096; Np = 4096; j.kind = 1; base = 1024; }
  else if (tile < 2304) { j.W = p.a_w_out; j.Wt = p.WaoT0(); j.gain = nullptr; j.K = 1024; j.Nsrc = 1024; Np = 1024; j.kind = 0; base = 2048; }
  else if (tile < 2560) { j.W = p.a_w_out + 1024 * 1024; j.Wt = p.WaoT1(); j.gain = nullptr; j.K = 1024; j.Nsrc = 1024; Np = 1024; j.kind = 0; base = 2304; }
  else if (tile < 3776) { j.W = p.b_w_in; j.Wt = p.WbT(); j.gain = p.b_norm; j.K = 1024; j.Nsrc = 4680; Np = 4864; j.kind = 4; base = 2560; }
  else if (tile < 4032) { j.W = p.b_w_out; j.Wt = p.WboT(); j.gain = nullptr; j.K = 1024; j.Nsrc = 1024; Np = 1024; j.kind = 0; base = 3776; }
  else if (tile < 4480) { j.W = p.c_w_in; j.Wt = p.WcT(); j.gain = p.c_norm; j.K = 1024; j.Nsrc = 1696; Np = 1792; j.kind = 2; base = 4032; }
  else if (tile < 4672) { j.W = p.c_w_uq; j.Wt = p.WuqT(); j.gain = p.c_q_lat_norm; j.K = 384; j.Nsrc = 1536; Np = 2048; j.kind = 3; base = 4480; }
  else if (tile < 4800) { j.W = p.c_w_ukv; j.Wt = p.WukvT(); j.gain = p.c_kv_lat_norm; j.K = 256; j.Nsrc = 2048; Np = 2048; j.kind = 0; base = 4672; }
  else                  { j.W = p.c_w_out; j.Wt = p.WcoT(); j.gain = nullptr; j.K = 1024; j.Nsrc = 1024; Np = 1024; j.kind = 0; base = 4800; }
  j.ntn = Np >> 6; j.lt = tile - base;
  return j;
}
DI void prep_load(const WJob& j, int t, float4 (&r)[4]) {
  const int tk = j.lt / j.ntn, tn = j.lt - tk * j.ntn;
  const int k0 = tk * 64, n0 = tn * 64, n4 = (t & 15) * 4, kq = t >> 4;
  const int ns = map_col(j.kind, n0 + n4);
#pragma unroll
  for (int i = 0; i < 4; ++i) {
    const int kl = kq + 16 * i;
    float4 v = make_float4(0.f, 0.f, 0.f, 0.f);
    if (ns >= 0) {
      v = ld_nt4(j.W + (long)(k0 + kl) * j.Nsrc + ns);
      if (j.gain) { const float g = j.gain[k0 + kl]; v.x *= g; v.y *= g; v.z *= g; v.w *= g; }
    }
    r[i] = v;
  }
}
DI void prep_store(const WJob& j, int t, const float4 (&r)[4], float* tl, bool active) {
  const int tk = j.lt / j.ntn, tn = j.lt - tk * j.ntn;
  const int k0 = tk * 64, n0 = tn * 64, n4 = (t & 15) * 4, kq = t >> 4;
  if (active) {
#pragma unroll
    for (int i = 0; i < 4; ++i) {
      float* d = tl + (kq + 16 * i) * 68 + n4;
      *(float4*)d = r[i];
    }
  }
  __syncthreads();
  if (active) {
#pragma unroll
    for (int jj = 0; jj < 2; ++jj) {
      const int c = t + 256 * jj, n_l = c >> 3, kc = c & 7;
      float v[8];
#pragma unroll
      for (int e = 0; e < 8; ++e) v[e] = tl[(kc * 8 + e) * 68 + n_l];
      *(uint4*)(j.Wt + (long)(n0 + n_l) * j.K + k0 + kc * 8) = pack8(v);
    }
  }
  __syncthreads();
}

DI void phase_prep(const Params& p, char* smem) {
  const int tp_ = otid();
  const int t = tp_ & 255, hb = tp_ >> 8;
  float* tl = (float*)(smem + hb * 17408);
  {
    const int stride = gridDim.x * 2;
    int tile = blockIdx.x * 2 + hb;
    float4 r[4], rn[4];
    WJob j = prep_job(p, min(tile, 5055));
    if (tile < 5056) prep_load(j, t, r);
    const int l = tp_ & 63;
    const int nw = gridDim.x * 8;
    int row = blockIdx.x * 8 + (tp_ >> 6);
    for (int tile0 = blockIdx.x * 2; tile0 < 5056 || row < 16384; tile0 += stride, tile += stride, row += nw) {
      const int nxt = tile + stride;
      WJob jn = prep_job(p, min(nxt, 5055));
      if (nxt < 5056) prep_load(jn, t, rn);
      float4 va[4];
      if (row < 16384) {
#pragma unroll
        for (int i = 0; i < 4; ++i) va[i] = ld_nt4(p.x + ((long)row * 256 + l + 64 * i) * 4);
      }
      prep_store(j, t, r, tl, tile < 5056);
      if (row < 16384) {
        float ssq = 0.f;
#pragma unroll
        for (int i = 0; i < 4; ++i) {
          const float4 v = va[i];
          uint2 ob; ob.x = cvtpk(v.x, v.y); ob.y = cvtpk(v.z, v.w);
          ((uint2*)p.xb())[(long)row * 256 + l + 64 * i] = ob;
          ssq += v.x * v.x + v.y * v.y + v.z * v.z + v.w * v.w;
        }
        ssq += shx(ssq, 1); ssq += shx(ssq, 2); ssq += shx(ssq, 4); ssq += shx(ssq, 8); ssq += shx(ssq, 16); ssq += shx(ssq, 32);
        if (l == 0) p.rss()[row] = ssq;
      }
      j = jn;
#pragma unroll
      for (int i = 0; i < 4; ++i) r[i] = rn[i];
    }
  }
  const long nthr = (long)gridDim.x * NT, tid = (long)blockIdx.x * NT + threadIdx.x;
  for (long i = tid; i < 5 * 16384; i += nthr) p.rss()[16384 + i] = 0.f;
  for (long i = tid; i < (long)16384 * 32; i += nthr) {
    const int j = (int)(i >> 14), m = (int)(i & 16383);
    const float ang = (float)p.pos[m] * c_inv[j];
    double f = (double)ang * 0.15915494309189535;
    f -= __builtin_rint(f);
    const float r = (float)(f * 6.283185307179586);
    p.rope()[i] = make_float2(cosf(r), sinf(r));
  }
}

constexpr int HT_ = 128 * 64;
DI int lds_byte(int r, int c) {
  const int st = (r >> 4) * 2 + (c >> 5), rr = r & 15, cc = c & 31, ob = rr * 64 + cc * 2;
  return st * 1024 + (ob ^ (((ob >> 9) & 1) << 5));
}
DI void stage_rc(int b, int& R, int& C) {
  const int st = b / 1024, sb = b % 1024, swz = sb ^ (((sb >> 9) & 1) << 5);
  R = (st >> 1) * 16 + swz / 64; C = (st & 1) * 32 + (swz % 64) / 2;
}
typedef f32x4 acc_t[2][2][4][2];

DI void gemm256(const u16* __restrict__ A, long arow0, long arow1, const u16* __restrict__ Bt, int bcol, int K, char* smem, acc_t& acc) {
  u16* shm = (u16*)smem;
#define SA(b, h) (shm + ((b) * 2 + (h)) * HT_)
#define SB(b, h) (shm + (4 + (b) * 2 + (h)) * HT_)
#define OPAQUE(v) asm volatile("" : "+v"(v))
#define STAGE(P, BASE, br, kt) do { const char* _gb = (const char*)(BASE + (long)(br) * K + (long)(kt) * 64);   \
      int _t16 = t16; OPAQUE(_t16);                                                                          \
      __builtin_amdgcn_global_load_lds((const unsigned*)(_gb + goff0),                                       \
        (__attribute__((address_space(3))) unsigned*)((char*)(P) + _t16), 16, 0, 0);                         \
      __builtin_amdgcn_global_load_lds((const unsigned*)(_gb + goff1),                                       \
        (__attribute__((address_space(3))) unsigned*)((char*)(P) + _t16 + 8192), 16, 0, 0); } while (0)
#define LDA(dst, b, h) do { int _ab = abase; OPAQUE(_ab); const char* _pa = (const char*)SA(b, h) + _ab;      \
    for (int m = 0; m < 4; ++m) for (int k = 0; k < 2; ++k)                                                  \
      dst[m][k] = *reinterpret_cast<const bf16x8*>(_pa + m * 2048 + k * 1024); } while (0)
#define LDB(dst, b, h) do { int _bb = bbase; OPAQUE(_bb); const char* _pb = (const char*)SB(b, h) + _bb;      \
    for (int n = 0; n < 2; ++n) for (int k = 0; k < 2; ++k)                                                  \
      dst[n][k] = *reinterpret_cast<const bf16x8*>(_pb + n * 2048 + k * 1024); } while (0)
#define MMA(ai, bj, At, Bt_) do { __builtin_amdgcn_s_setprio(1);                                              \
    for (int m = 0; m < 4; ++m) for (int n = 0; n < 2; ++n) for (int k = 0; k < 2; ++k)                       \
      acc[ai][bj][m][n] = __builtin_amdgcn_mfma_f32_16x16x32_bf16(Bt_[n][k], At[m][k], acc[ai][bj][m][n], 0, 0, 0); \
    __builtin_amdgcn_s_setprio(0); } while (0)
#define WAIT_V(n) asm volatile("s_waitcnt vmcnt(" #n ")" ::: "memory")
#define WAIT_L(n) asm volatile("s_waitcnt lgkmcnt(" #n ")" ::: "memory")
#define BAR __builtin_amdgcn_s_barrier()
#define SCHED __builtin_amdgcn_sched_barrier(0)
  const int tid_ = otid();
  const int wid = tid_ >> 6, lane = tid_ & 63, wr = wid >> 2, wc = wid & 3, fr = lane & 15, fq = lane >> 4;
#pragma unroll
  for (int a = 0; a < 2; ++a)
#pragma unroll
    for (int b = 0; b < 2; ++b)
#pragma unroll
      for (int m = 0; m < 4; ++m)
#pragma unroll
        for (int n = 0; n < 2; ++n) acc[a][b][m][n] = f32x4{0.f, 0.f, 0.f, 0.f};
  bf16x8 At[4][2], B0[2][2], B1[2][2];
  const int nt = K / 64;
  unsigned goff0, goff1;
  { int r_, c_; stage_rc(tid_ * 16, r_, c_); goff0 = (unsigned)(r_ * K + c_) * 2u; stage_rc(tid_ * 16 + 8192, r_, c_); goff1 = (unsigned)(r_ * K + c_) * 2u; }
  const int swz_ = lds_byte(fr, fq * 8);
  const int abase = wr * 8192 + swz_, bbase = wc * 4096 + swz_;
  const int t16 = tid_ * 16;
  const int bcol1 = bcol + 128;
  STAGE(SB(0, 0), Bt, bcol, 0); STAGE(SA(0, 0), A, arow0, 0);
  STAGE(SB(0, 1), Bt, bcol1, 0); STAGE(SA(0, 1), A, arow1, 0);
  if (wr == 1) BAR;
  WAIT_V(4); BAR;
  STAGE(SB(1, 0), Bt, bcol, 1); STAGE(SA(1, 0), A, arow0, 1); STAGE(SB(1, 1), Bt, bcol1, 1);
  WAIT_V(6); BAR;
  for (int t = 0; t < nt - 2; t += 2) {
    LDB(B0, 0, 0); SCHED; LDA(At, 0, 0); STAGE(SA(1, 1), A, arow1, t + 1);
    WAIT_L(8); BAR; WAIT_L(0); MMA(0, 0, At, B0); BAR; SCHED;
    LDB(B1, 0, 1); STAGE(SB(0, 0), Bt, bcol, t + 2);
    BAR; WAIT_L(0); MMA(0, 1, At, B1); BAR;
    LDA(At, 0, 1); STAGE(SA(0, 0), A, arow0, t + 2);
    BAR; WAIT_L(0); MMA(1, 0, At, B0); BAR; SCHED;
    STAGE(SB(0, 1), Bt, bcol1, t + 2);
    WAIT_V(6); BAR; MMA(1, 1, At, B1); BAR;
    LDB(B0, 1, 0); SCHED; LDA(At, 1, 0); STAGE(SA(0, 1), A, arow1, t + 2);
    WAIT_L(8); BAR; WAIT_L(0); MMA(0, 0, At, B0); BAR; SCHED;
    LDB(B1, 1, 1); STAGE(SB(1, 0), Bt, bcol, t + 3);
    BAR; WAIT_L(0); MMA(0, 1, At, B1); BAR;
    LDA(At, 1, 1); STAGE(SA(1, 0), A, arow0, t + 3);
    BAR; WAIT_L(0); MMA(1, 0, At, B0); BAR; SCHED;
    STAGE(SB(1, 1), Bt, bcol1, t + 3);
    WAIT_V(6); BAR; MMA(1, 1, At, B1); BAR;
  }
  { LDB(B0, 0, 0); LDA(At, 0, 0); STAGE(SA(1, 1), A, arow1, nt - 1);
    BAR; WAIT_L(0); MMA(0, 0, At, B0); BAR;
    LDB(B1, 0, 1); BAR; WAIT_L(0); MMA(0, 1, At, B1); BAR;
    LDA(At, 0, 1); WAIT_V(4); BAR; WAIT_L(0); MMA(1, 0, At, B0); MMA(1, 1, At, B1); BAR; }
  { LDB(B0, 1, 0); LDA(At, 1, 0); WAIT_V(2); BAR; WAIT_L(0); MMA(0, 0, At, B0); BAR;
    LDB(B1, 1, 1); WAIT_V(0); BAR; WAIT_L(0); MMA(0, 1, At, B1); BAR;
    LDA(At, 1, 1); BAR; WAIT_L(0); MMA(1, 0, At, B0); MMA(1, 1, At, B1); BAR; }
  if (wr == 0) BAR;
#undef SA
#undef SB
#undef STAGE
#undef OPAQUE
#undef LDA
#undef LDB
#undef MMA
#undef WAIT_V
#undef WAIT_L
#undef BAR
#undef SCHED
  __syncthreads();
}

DI void dump_half(const acc_t& acc, int ai, char* smem) {
  const int tid_ = otid();
  const int wid = tid_ >> 6, lane = tid_ & 63, wr = wid >> 2, wc = wid & 3, fr = lane & 15, fq = lane >> 4;
#pragma unroll
  for (int bj = 0; bj < 2; ++bj) {
    float* Cq = (float*)(smem + bj * LDS_Q);
#pragma unroll
    for (int m = 0; m < 4; ++m)
#pragma unroll
      for (int n = 0; n < 2; ++n)
        *(f32x4*)(Cq + (wr * 64 + m * 16 + fr) * CS_LD + wc * 32 + n * 16 + fq * 4) = acc[ai][bj][m][n];
  }
}

enum { EPI_RES = 0, EPI_CONV = 1, EPI_BIN = 2, EPI_CIN = 3, EPI_UQ = 4, EPI_UKV = 5 };

DI void epi_res(const Params& p, char* smem, const float* rs, int t, int m0, int n0, float* rss_next, const float* res_in) {
  const float* Cs = (const float*)smem;
  const int c4 = (t & 31) * 4;
#pragma unroll 8
  for (int ps = 0; ps < 16; ++ps) {
    const int row = (t >> 5) + 8 * ps;
    const float4 c = *(const float4*)(Cs + row * CS_LD + c4);
    const long o = (long)(m0 + row) * 1024 + n0 + c4;
    const uint2 xr = *(const uint2*)(p.xb() + o);
    float4 v = make_float4(bflo(xr.x) + c.x, bfhi(xr.x) + c.y, bflo(xr.y) + c.z, bfhi(xr.y) + c.w);
    if (res_in == nullptr) {
      { f32x4 w_ = {v.x, v.y, v.z, v.w}; __builtin_nontemporal_store(w_, (f32x4*)(p.out + o)); }
    } else {
      uint2 b; b.x = cvtpk(v.x, v.y); b.y = cvtpk(v.z, v.w);
      st_wt8(p.xb() + o, b);
    }
    if (rss_next) {
      float q = v.x * v.x + v.y * v.y + v.z * v.z + v.w * v.w;
      q += shx(q, 1); q += shx(q, 2); q += shx(q, 4); q += shx(q, 8); q += shx(q, 16);
      if ((t & 31) == 0) atomicAdd(rss_next + m0 + row, q);
    }
  }
}

DI void epi_conv(const Params& p, char* smem, const float* rs, int t, int layer, int m0h, int ai, int pm, int nt, float* uprev) {
  const float* Cs = (const float*)smem;
  const int c4 = (t & 7) * 4;
  const int ch = nt * 32 + c4;
  const float4 w0 = *(const float4*)(p.a_conv_w + layer * 3072 + ch);
  const float4 w1 = *(const float4*)(p.a_conv_w + layer * 3072 + 1024 + ch);
  const float4 w2 = *(const float4*)(p.a_conv_w + layer * 3072 + 2048 + ch);
  const float4 cb = *(const float4*)(p.a_conv_b + layer * 1024 + ch);
  const bool seq_start = ((m0h & 2047) == 0);
#pragma unroll 2
  for (int ps = 0; ps < 4; ++ps) {
    const int row = (t >> 3) + 32 * ps;
    const float ra = rs[row];
    const float* c0 = Cs + row * CS_LD + c4;
    const float4 bg = *(const float4*)(c0);
    const float4 cga = *(const float4*)(c0 + 32), hva = *(const float4*)(c0 + 64);
    const float4 z = *(const float4*)(c0 + 96);
    const float ra2 = ra * ra;
    const float4 ua = make_float4(cga.x * hva.x * ra2, cga.y * hva.y * ra2, cga.z * hva.z * ra2, cga.w * hva.w * ra2);
    const float4 pg = make_float4(bg.x * ra * silu_f(z.x * ra), bg.y * ra * silu_f(z.y * ra), bg.z * ra * silu_f(z.z * ra), bg.w * ra * silu_f(z.w * ra));
    if (row >= 126) {
      if (ai == 0) *(float4*)(uprev + (row - 126) * 32 + c4) = ua;
      else *(float4*)(p.convUL() + ((long)pm * 2 + (row - 126)) * 1024 + ch) = ua;
    }
    float4 ub, uc;
    bool defer = false;
    if (row >= 2) {
      const float rb = rs[row - 1], rc = rs[row - 2];
      const float rb2 = rb * rb, rc2 = rc * rc;
      const float4 cgb = *(const float4*)(c0 - CS_LD + 32), hvb = *(const float4*)(c0 - CS_LD + 64);
      const float4 cgc = *(const float4*)(c0 - 2 * CS_LD + 32), hvc = *(const float4*)(c0 - 2 * CS_LD + 64);
      ub = make_float4(cgb.x * hvb.x * rb2, cgb.y * hvb.y * rb2, cgb.z * hvb.z * rb2, cgb.w * hvb.w * rb2);
      uc = make_float4(cgc.x * hvc.x * rc2, cgc.y * hvc.y * rc2, cgc.z * hvc.z * rc2, cgc.w * hvc.w * rc2);
    } else if (ai == 1) {
      const float4 p1 = *(const float4*)(uprev + 32 + c4), p0 = *(const float4*)(uprev + c4);
      if (row == 1) {
        const float rb = rs[0]; const float rb2 = rb * rb;
        const float4 cgb = *(const float4*)(c0 - CS_LD + 32), hvb = *(const float4*)(c0 - CS_LD + 64);
        ub = make_float4(cgb.x * hvb.x * rb2, cgb.y * hvb.y * rb2, cgb.z * hvb.z * rb2, cgb.w * hvb.w * rb2);
        uc = p1;
      } else { ub = p1; uc = p0; }
    } else if (seq_start) {
      uc = make_float4(0.f, 0.f, 0.f, 0.f);
      if (row == 1) {
        const float rb = rs[0]; const float rb2 = rb * rb;
        const float4 cgb = *(const float4*)(c0 - CS_LD + 32), hvb = *(const float4*)(c0 - CS_LD + 64);
        ub = make_float4(cgb.x * hvb.x * rb2, cgb.y * hvb.y * rb2, cgb.z * hvb.z * rb2, cgb.w * hvb.w * rb2);
      } else ub = uc;
    } else {
      defer = true;
      ub = uc = make_float4(0.f, 0.f, 0.f, 0.f);
      *(float4*)(p.convPF() + ((long)pm * 2 + row) * 1024 + ch) = pg;
      *(float4*)(p.convUF() + ((long)pm * 2 + row) * 1024 + ch) = ua;
    }
    if (!defer) {
      const float y0 = (w0.x * uc.x + w1.x * ub.x + w2.x * ua.x + cb.x) * pg.x;
      const float y1 = (w0.y * uc.y + w1.y * ub.y + w2.y * ua.y + cb.y) * pg.y;
      const float y2 = (w0.z * uc.z + w1.z * ub.z + w2.z * ua.z + cb.z) * pg.z;
      const float y3 = (w0.w * uc.w + w1.w * ub.w + w2.w * ua.w + cb.w) * pg.w;
      uint2 o; o.x = cvtpk(y0, y1); o.y = cvtpk(y2, y3);
      st_wt8(p.vb() + ((long)(m0h + row)) * 1024 + ch, o);
    }
  }
}

DI void conv_fixup(const Params& p, int layer, int pm) {
  if ((pm & 7) != 0) {
    for (int idx = otid(); idx < 2048; idx += NT) {
      const int row = idx >> 10, ch = idx & 1023;
      const float* ULp = p.convUL() + ((long)(pm - 1) * 2) * 1024 + ch;
      const float uf0 = p.convUF()[((long)pm * 2) * 1024 + ch];
      const float ufr = p.convUF()[((long)pm * 2 + row) * 1024 + ch];
      const float u_m1 = (row == 0) ? ULp[1024] : uf0;
      const float u_m2 = (row == 0) ? ULp[0] : ULp[1024];
      const float y = p.a_conv_w[layer * 3072 + ch] * u_m2 + p.a_conv_w[layer * 3072 + 1024 + ch] * u_m1 +
                      p.a_conv_w[layer * 3072 + 2048 + ch] * ufr + p.a_conv_b[layer * 1024 + ch];
      const float o = y * p.convPF()[((long)pm * 2 + row) * 1024 + ch];
      p.vb()[((long)pm * 256 + row) * 1024 + ch] = (u16)(cvtpk(o, 0.f) & 0xFFFFu);
    }
    asm volatile("s_waitcnt vmcnt(0)" ::: "memory");
    __syncthreads();
  }
}

DI u16* vT1_ptr(const Params& p, int bh) {
  return (bh < 64) ? p.qreg() + 16777216 + (long)bh * 131072 : p.kreg() + 16777216 + (long)(bh - 64) * 131072;
}

template <bool SILU>
DI void epi_rowwise_bf16(char* smem, const float* rs, int t, u16* dst, int ld, int m0, int col0, float* rss_acc) {
  const float* Cs = (const float*)smem;
  const int c4 = (t & 31) * 4;
#pragma unroll 4
  for (int ps = 0; ps < 16; ++ps) {
    const int row = (t >> 5) + 8 * ps;
    const float rr = rs[row];
    const float4 c = *(const float4*)(Cs + row * CS_LD + c4);
    float a = c.x * rr, b = c.y * rr, cc = c.z * rr, d = c.w * rr;
    if (SILU) { a = silu_f(a); b = silu_f(b); cc = silu_f(cc); d = silu_f(d); }
    uint2 o; o.x = cvtpk(a, b); o.y = cvtpk(cc, d);
    st_wt8(dst + (long)(m0 + row) * ld + col0 + c4, o);
    if (rss_acc) {
      float q = a * a + b * b + cc * cc + d * d;
      q += shx(q, 1); q += shx(q, 2); q += shx(q, 4); q += shx(q, 8); q += shx(q, 16);
      if ((t & 31) == 0) atomicAdd(rss_acc + m0 + row, q);
    }
  }
}

struct VReg { uint4 v[8]; };
DI void epi_vT_read(char* smem, const float* rs, int colc, int rh, VReg& vr) {
  const float* Cs = (const float*)smem;
#pragma unroll
  for (int i8 = 0; i8 < 8; ++i8) {
    float v[8];
#pragma unroll
    for (int e = 0; e < 8; ++e) { const int row = rh * 64 + i8 * 8 + e; v[e] = Cs[row * CS_LD + colc] * rs[row]; }
    vr.v[i8] = pack8(v);
  }
}
DI void vT_park(char* smem, int trow, int tcol, const VReg& vr) {
  float* Cs = (float*)smem;
#pragma unroll
  for (int i8 = 0; i8 < 8; ++i8) *(uint4*)(Cs + trow * CS_LD + tcol + 4 * i8) = vr.v[i8];
}

DI void row_scale_store(const float* cr, u16* dst, int n4, float sc, const float* g) {
#pragma unroll
  for (int i = 0; i < n4; ++i) {
    const float4 f = *(const float4*)(cr + 4 * i);
    float4 gg = make_float4(1.f, 1.f, 1.f, 1.f);
    if (g) gg = *(const float4*)(g + 4 * i);
    uint2 o; o.x = cvtpk(f.x * sc * gg.x, f.y * sc * gg.y); o.y = cvtpk(f.z * sc * gg.z, f.w * sc * gg.w);
    *(uint2*)(dst + 4 * i) = o;
  }
}
DI void rope_store(const float* srcA, const float* srcB, u16* dstA, u16* dstB, int half, float sc, const float* ga, const float* gb,
                   const float2* rp, int rstep, float post) {
#pragma unroll
  for (int j4 = 0; j4 < half / 4; ++j4) {
    const float4 a = *(const float4*)(srcA + 4 * j4), b = *(const float4*)(srcB + 4 * j4);
    float4 g1 = make_float4(1.f, 1.f, 1.f, 1.f), g2 = g1;
    if (ga) { g1 = *(const float4*)(ga + 4 * j4); g2 = *(const float4*)(gb + 4 * j4); }
    const float2 c0 = rp[(long)(4 * j4) * rstep], c1 = rp[(long)(4 * j4 + 1) * rstep], c2 = rp[(long)(4 * j4 + 2) * rstep], c3 = rp[(long)(4 * j4 + 3) * rstep];
    const float a0 = a.x * sc * g1.x, a1 = a.y * sc * g1.y, a2 = a.z * sc * g1.z, a3 = a.w * sc * g1.w;
    const float b0 = b.x * sc * g2.x, b1 = b.y * sc * g2.y, b2 = b.z * sc * g2.z, b3 = b.w * sc * g2.w;
    uint2 oa, ob;
    oa.x = cvtpk((a0 * c0.x - b0 * c0.y) * post, (a1 * c1.x - b1 * c1.y) * post);
    oa.y = cvtpk((a2 * c2.x - b2 * c2.y) * post, (a3 * c3.x - b3 * c3.y) * post);
    ob.x = cvtpk((b0 * c0.x + a0 * c0.y) * post, (b1 * c1.x + a1 * c1.y) * post);
    ob.y = cvtpk((b2 * c2.x + a2 * c2.y) * post, (b3 * c3.x + a3 * c3.y) * post);
    *(uint2*)(dstA + 4 * j4) = oa;
    *(uint2*)(dstB + 4 * j4) = ob;
  }
}
DI float row_ssq(const float* cr, int n4) {
  float s = 0.f;
#pragma unroll 4
  for (int i = 0; i < n4; ++i) { const float4 f = *(const float4*)(cr + 4 * i); s += f.x * f.x + f.y * f.y + f.z * f.z + f.w * f.w; }
  return s;
}

DI void epi_bin(const Params& p, char* smem, const float* rs, int t, int m0, int nt, VReg& vr) {
  const float* Cs = (const float*)smem;
  const int bidx = m0 >> 11, s0 = m0 & 2047;
  if (nt < 16) {
    const int row = t & 127, hh = t >> 7;
    const bool isq = nt < 8;
    const int head = (nt & 7) * 2 + hh;
    const float* cr = Cs + row * CS_LD + hh * 64;
    const float ssq = row_ssq(cr, 16);
    const float rr = rs[row];
    const float sc = rr * rsqrtf(rr * rr * ssq * (1.f / 64.f) + EPS_);
    const float* gn = isq ? p.b_q_norm : p.b_k_norm;
    const float post = isq ? 0.125f * LOG2E_ : 1.f;
    const int gm = m0 + row;
    rope_store(cr, cr + 32, (u16*)const_cast<float*>(cr), (u16*)const_cast<float*>(cr + 32), 32, sc, gn, gn + 32, p.rope() + gm, 16384, post);
  } else if (nt < 24) {
    epi_vT_read(smem, rs, t & 127, t >> 7, vr);
  } else if (nt < 32) {
    epi_rowwise_bf16<true>(smem, rs, t, p.szb(), 1024, m0, (nt - 24) * 128, nullptr);
  } else if (nt < 36) {
    const int row = t & 127, hh = t >> 7;
    const float* cr = Cs + row * CS_LD + hh * 64;
    const float rr = rs[row];
    const int gm = m0 + row;
    rope_store(cr, cr + 16, (u16*)const_cast<float*>(cr), (u16*)const_cast<float*>(cr + 16), 16, rr, nullptr, nullptr, p.rope() + gm, 32768, 1.f);
    row_scale_store(cr + 32, (u16*)const_cast<float*>(cr + 32), 8, rr, nullptr);
  } else if (nt == 36) {
    if (t < 128) {
      const int row = t;
      const float* cr = Cs + row * CS_LD;
      const float rr = rs[row];
      const int gm = m0 + row;
      rope_store(cr, cr + 16, (u16*)const_cast<float*>(cr), (u16*)const_cast<float*>(cr + 16), 16, rr, nullptr, nullptr, p.rope() + gm, 32768, 1.f);
      row_scale_store(cr + 32, (u16*)const_cast<float*>(cr + 32), 8, rr, nullptr);
    } else {
      const int row = t - 128;
      const float* cr = Cs + row * CS_LD + 64;
      const float sc = rs[row] * 0.044194173824159216f;
      const float4 f0 = *(const float4*)(cr), f1 = *(const float4*)(cr + 4);
      float* dst = p.wif() + (long)(m0 + row) * 8;
      *(float4*)(dst) = make_float4(f0.x * sc, f0.y * sc, f0.z * sc, f0.w * sc);
      *(float4*)(dst + 4) = make_float4(f1.x * sc, f1.y * sc, f1.z * sc, f1.w * sc);
    }
  }
}

DI void copy_bin(const Params& p, char* smem, int t, int m0, int nt, const VReg& vr) {
  const float* Cs = (const float*)smem;
  const int bidx = m0 >> 11, s0 = m0 & 2047;
  if (nt < 16) {
    u16* base = (nt < 8 ? p.qreg() : p.kreg());
#pragma unroll
    for (int hh = 0; hh < 2; ++hh) {
      u16* dst = base + ((long)((bidx * 16 + (nt & 7) * 2 + hh) * 2048 + s0)) * 64;
#pragma unroll
      for (int it = 0; it < 4; ++it) {
        const int c = t + 256 * it, row = c >> 3, ch = c & 7;
        const uint4 v = *(const uint4*)(Cs + row * CS_LD + hh * 64 + 4 * ch + (ch >= 4 ? 16 : 0));
        st_wt16(dst + (long)c * 8, v);
      }
    }
  } else if (nt < 24) {
    vT_park(smem, t & 127, (t >> 7) * 32, vr);
  } else if (nt >= 32 && nt < 36) {
#pragma unroll
    for (int hh = 0; hh < 2; ++hh) {
      u16* dst = p.qib() + ((long)m0 * 8 + (nt - 32) * 2 + hh) * 64;
#pragma unroll
      for (int it = 0; it < 4; ++it) {
        const int c = t + 256 * it, row = c >> 3, ch = c & 7;
        const uint4 v = *(const uint4*)(Cs + row * CS_LD + hh * 64 + 4 * ch + (ch >= 4 ? 16 : (ch >= 2 ? 8 : 0)));
        st_wt16(dst + (long)row * 512 + ch * 8, v);
      }
    }
  } else if (nt == 36) {
    u16* dst = p.kib() + (long)m0 * 64;
#pragma unroll
    for (int it = 0; it < 4; ++it) {
      const int c = t + 256 * it, row = c >> 3, ch = c & 7;
      const uint4 v = *(const uint4*)(Cs + row * CS_LD + 4 * ch + (ch >= 4 ? 16 : (ch >= 2 ? 8 : 0)));
      st_wt16(dst + (long)c * 8, v);
    }
  }
}

DI void copy2_bin(const Params& p, char* smem, int t, int m0, int nt) {
  if (nt >= 16 && nt < 24) {
    const float* Cs = (const float*)smem;
    const int bidx = m0 >> 11, s0 = m0 & 2047;
#pragma unroll
    for (int it = 0; it < 8; ++it) {
      const int c = t + 256 * it, dvr = c >> 4, ch = c & 15;
      const uint4 v = *(const uint4*)(Cs + dvr * CS_LD + 4 * ch);
      st_wt16(vT1_ptr(p, bidx * 16 + (nt - 16) * 2 + (dvr >> 6)) + (long)(dvr & 63) * 2048 + s0 + ch * 8, v);
    }
  }
}

DI void epi_cin(const Params& p, char* smem, const float* rs, int t, int m0, int nt) {
  if (nt < 3) epi_rowwise_bf16<false>(smem, rs, t, p.cqb(), 384, m0, nt * 128, p.rss() + 4 * 16384);
  else if (nt < 5) epi_rowwise_bf16<false>(smem, rs, t, p.ckvb(), 256, m0, (nt - 3) * 128, p.rss() + 5 * 16384);
  else if (nt < 13) epi_rowwise_bf16<true>(smem, rs, t, p.szb(), 1024, m0, (nt - 5) * 128, nullptr);
  else {
    const float* Cs = (const float*)smem;
    const int c4 = (t & 7) * 4;
#pragma unroll
    for (int ps = 0; ps < 4; ++ps) {
      const int row = (t >> 3) + 32 * ps;
      const float rr = rs[row];
      const float4 c = *(const float4*)(Cs + row * CS_LD + c4);
      *(float4*)(p.krf() + (long)(m0 + row) * 32 + c4) = make_float4(c.x * rr, c.y * rr, c.z * rr, c.w * rr);
    }
  }
}

DI void epi_uq(const Params& p, char* smem, const float* rs, int t, int m0, int head) {
  const float* Cs = (const float*)smem;
  const int row = t & 127, hf = t >> 7;
  const float* cr = Cs + row * CS_LD;
  const float ssq = row_ssq(cr, 24);
  const float rr = rs[row];
  const float sc = rr * rsqrtf(rr * rr * ssq * (1.f / 96.f) + EPS_) * (0.10206207261596575f * LOG2E_);
  const int gm = m0 + row;
  const float* gn = p.c_q_norm;
  float* cw = const_cast<float*>(cr);
  __syncthreads();
  if (hf == 0) {
    row_scale_store(cr, (u16*)cw, 12, sc, gn);
  } else {
    row_scale_store(cr + 48, (u16*)(cw + 48), 4, sc, gn + 48);
    rope_store(cr + 64, cr + 80, (u16*)(cw + 64), (u16*)(cw + 80), 16, sc, gn + 64, gn + 80, p.rope() + gm, 32768, 1.f);
  }
}
DI void copy_uq(const Params& p, char* smem, int t, int m0, int head) {
  const float* Cs = (const float*)smem;
  u16* dst = p.qreg() + ((long)(((m0 >> 11) * 16 + head) * 2048 + (m0 & 2047))) * 96;
#pragma unroll
  for (int it = 0; it < 6; ++it) {
    const int c = t + 256 * it, row = c / 12, ch = c - row * 12;
    const int slot = 4 * ch + (ch >= 10 ? 40 : (ch >= 8 ? 32 : (ch >= 6 ? 24 : 0)));
    const uint4 v = *(const uint4*)(Cs + row * CS_LD + slot);
    st_wt16(dst + (long)c * 8, v);
  }
}

DI void epi_ukv(const Params& p, char* smem, const float* rs, int t, int m0, int head, VReg& vr) {
  const float* Cs = (const float*)smem;
  const int bidx = m0 >> 11, s0 = m0 & 2047;
  if (t < 128) {
    const int row = t, gm = m0 + row;
    const float* cr = Cs + row * CS_LD;
    const float rr = rs[row];
    const float* kr = p.krf() + (long)gm * 32;
    const float ssq = rr * rr * row_ssq(cr, 16) + row_ssq(kr, 8);
    const float sc = rsqrtf(ssq * (1.f / 96.f) + EPS_);
    const float* gn = p.c_k_norm;
    float* cw = const_cast<float*>(cr);
    row_scale_store(cr, (u16*)cw, 16, rr * sc, gn);
    rope_store(kr, kr + 16, (u16*)(cw + 32), (u16*)(cw + 40), 16, sc, gn + 64, gn + 80, p.rope() + gm, 32768, 1.f);
  } else {
    const int u = t - 128;
    epi_vT_read(smem, rs, 64 + (u & 63), u >> 6, vr);
  }
}

DI void copy_ukv(const Params& p, char* smem, int t, int m0, int head, const VReg& vr) {
  const float* Cs = (const float*)smem;
  if (t >= 128) { const int u = t - 128; vT_park(smem, 2 * (u & 63) + (u >> 6), 64, vr); }
  u16* dst = p.kreg() + ((long)(((m0 >> 11) * 16 + head) * 2048 + (m0 & 2047))) * 96;
#pragma unroll
  for (int it = 0; it < 6; ++it) {
    const int c = t + 256 * it, row = c / 12, ch = c - row * 12;
    const uint4 v = *(const uint4*)(Cs + row * CS_LD + 4 * ch);
    st_wt16(dst + (long)c * 8, v);
  }
}

DI void copy2_ukv(const Params& p, char* smem, int t, int m0, int head) {
  const float* Cs = (const float*)smem;
  u16* base = (u16*)p.out + (long)((m0 >> 11) * 16 + head) * 131072 + (m0 & 2047);
#pragma unroll
  for (int it = 0; it < 4; ++it) {
    const int c = t + 256 * it, dvr = c >> 4, ch = c & 15;
    const uint4 v = *(const uint4*)(Cs + (2 * dvr + (ch >> 3)) * CS_LD + 64 + 4 * (ch & 7));
    st_wt16(base + (long)dvr * 2048 + ch * 8, v);
  }
}

DI bf16x8 packstep(const f32x16& x, int s) {
  uint4 w;
  w.x = cvtpk(x[8 * s], x[8 * s + 1]); w.y = cvtpk(x[8 * s + 2], x[8 * s + 3]);
  w.z = cvtpk(x[8 * s + 4], x[8 * s + 5]); w.w = cvtpk(x[8 * s + 6], x[8 * s + 7]);
  return __builtin_bit_cast(bf16x8, w);
}

template <int DQK, bool MASKED>
DI void attn_compute(const char* bs, const bf16x8 (&qf)[DQK / 16], f32x16 (&O)[2], f32x16& lsumv, const f32x16& nsh16, float nshift,
                     unsigned mwx, unsigned mwy, int lr, int lh) {
  constexpr int KS = DQK * 2 + 16, NS = DQK / 16, VS = 136;
  f32x16 st[2];
#pragma unroll
  for (int i = 0; i < 2; ++i) {
    if (MASKED) {
      const unsigned wsh = (i == 0 ? mwx : mwy) >> (4 * lh);
#pragma unroll
      for (int r = 0; r < 16; ++r) {
        const unsigned m = (unsigned)__builtin_amdgcn_sbfe((int)wsh, (r & 3) + 8 * (r >> 2), 1);
        st[i][r] = __uint_as_float((m & __float_as_uint(nshift)) | (~m & 0xC61C4000u));
      }
    }
#pragma unroll
    for (int s = 0; s < NS; ++s) {
      const bf16x8 kf = *(const bf16x8*)(bs + (32 * i + lr) * KS + s * 32 + lh * 16);
      st[i] = mfma32(kf, qf[s], (!MASKED && s == 0) ? nsh16 : st[i]);
    }
  }
#pragma unroll
  for (int i = 0; i < 2; ++i) {
#pragma unroll
    for (int r = 0; r < 16; ++r) st[i][r] = __builtin_amdgcn_exp2f(st[i][r]);
    lsumv += st[i];
  }
#pragma unroll
  for (int i = 0; i < 2; ++i)
#pragma unroll
    for (int s2 = 0; s2 < 2; ++s2) {
      const bf16x8 pf = packstep(st[i], s2);
#pragma unroll
      for (int j = 0; j < 2; ++j) {
        const char* vp = bs + 13312 + (32 * j + lr) * VS + (32 * i + 16 * s2 + 4 * lh) * 2;
        const s16x4 v0 = *(const s16x4*)(vp);
        const s16x4 v1 = *(const s16x4*)(vp + 16);
        const bf16x8 vf = __builtin_shufflevector(v0, v1, 0, 1, 2, 3, 4, 5, 6, 7);
        O[j] = mfma32(vf, pf, O[j]);
      }
    }
}

template <int DQK, bool MASKED>
DI void attn_item(const Params& p, char* smem, int bidx, int h, int qt, const u16* vTb) {
  constexpr int KS = DQK * 2 + 16;
  constexpr int NS = DQK / 16;
  constexpr int KCH = DQK / 8;
  constexpr int VS = 136;
  constexpr int BUF = 22016;
  const int t = otid(), l = t & 63, w = t >> 6, lr = l & 31, lh = l >> 5;
  const int bh = bidx * 16 + h;
  const int q0 = qt * 256;
  const int nkt = 4 * qt + 4;
  const int nkt_w = 4 * qt + (w >> 1) + 1;
  const u16* Kg = p.kreg() + (long)bh * 2048 * DQK;
  const u16* Qg = p.qreg() + ((long)bh * 2048 + q0 + 32 * w + lr) * DQK + 8 * lh;
  bf16x8 qf[NS];
#pragma unroll
  for (int s = 0; s < NS; ++s) qf[s] = *(const bf16x8*)(Qg + 16 * s);
  const unsigned* mrow = p.mask() + ((long)(bidx * 2048 + q0 + 32 * w + lr)) * 64;

  f32x16 O[2];
#pragma unroll
  for (int j = 0; j < 2; ++j)
#pragma unroll
    for (int r = 0; r < 16; ++r) O[j][r] = 0.f;
  f32x16 lsumv;
#pragma unroll
  for (int r = 0; r < 16; ++r) lsumv[r] = 0.f;
  float nshift;
  {
    const float* gq = MASKED ? p.b_q_norm : p.c_q_norm;
    const float* gk = MASKED ? p.b_k_norm : p.c_k_norm;
    float mq = fabsf(gq[l]), mk = fabsf(gk[l]);
    if (DQK > 64 && l + 64 < DQK) { mq = fmaxf(mq, fabsf(gq[l + 64])); mk = fmaxf(mk, fabsf(gk[l + 64])); }
#pragma unroll
    for (int m = 1; m < 64; m <<= 1) { mq = fmaxf(mq, shx(mq, m)); mk = fmaxf(mk, shx(mk, m)); }
    const float sq = (DQK == 64) ? 8.f : 9.797958971132712f;
    nshift = -fminf(sq * mq * mk * LOG2E_, 60.f);
  }
  f32x16 nsh16;
#pragma unroll
  for (int r = 0; r < 16; ++r) nsh16[r] = nshift;

  const int kr0 = t / KCH, kc0 = t - kr0 * KCH;
  const int c1 = t + 512, kr1 = c1 / KCH, kc1 = c1 - kr1 * KCH;
  const bool has1 = (DQK > 64) && (c1 < 64 * KCH);
  const u16* kg0 = Kg + (long)kr0 * DQK + kc0 * 8;
  const u16* kg1 = Kg + (long)(has1 ? kr1 : 0) * DQK + (has1 ? kc1 : 0) * 8;
  const u16* vg = vTb + (long)(t >> 3) * 2048 + (t & 7) * 8;
  const int kw0 = kr0 * KS + kc0 * 16, kw1 = kr1 * KS + kc1 * 16, vw = 13312 + (t >> 3) * VS + (t & 7) * 16;
  uint4 ka0, ka1, va, kb0, kb1, vb_;
#define ALOAD(K0, K1, V, kt)                                               \
  {                                                                        \
    K0 = *(const uint4*)(kg0 + (long)(kt) * 64 * DQK);                     \
    if (DQK > 64) K1 = *(const uint4*)(kg1 + (long)(kt) * 64 * DQK);       \
    V = *(const uint4*)(vg + (kt) * 64);                                   \
  }
#define AWRITE(K0, K1, V, buf)                                             \
  {                                                                        \
    char* bs_ = smem + (buf) * BUF;                                        \
    *(uint4*)(bs_ + kw0) = K0;                                             \
    if (has1) *(uint4*)(bs_ + kw1) = K1;                                   \
    *(uint2*)(bs_ + vw) = make_uint2(V.x, V.y);                            \
    *(uint2*)(bs_ + vw + 8) = make_uint2(V.z, V.w);                        \
  }
  ALOAD(ka0, ka1, va, 0);
  ALOAD(kb0, kb1, vb_, 1);
  uint4 mwc = make_uint4(0u, 0u, 0u, 0u), mwn = mwc;
  if (MASKED) mwc = *(const uint4*)(mrow);
  AWRITE(ka0, ka1, va, 0);
  __syncthreads();
  for (int kt = 0; kt < nkt; kt += 2) {
    const int k2 = min(kt + 2, nkt - 1), k3 = min(kt + 3, nkt - 1);
    ALOAD(ka0, ka1, va, k2);
    if (MASKED) mwn = *(const uint4*)(mrow + 2 * (kt + 2));
    __builtin_amdgcn_sched_barrier(0);
    if (kt < nkt_w) attn_compute<DQK, MASKED>(smem, qf, O, lsumv, nsh16, nshift, mwc.x, mwc.y, lr, lh);
    __builtin_amdgcn_sched_barrier(0);
    AWRITE(kb0, kb1, vb_, 1);
    __syncthreads();
    ALOAD(kb0, kb1, vb_, k3);
    __builtin_amdgcn_sched_barrier(0);
    if (kt + 1 < nkt_w) attn_compute<DQK, MASKED>(smem + BUF, qf, O, lsumv, nsh16, nshift, mwc.z, mwc.w, lr, lh);
    __builtin_amdgcn_sched_barrier(0);
    AWRITE(ka0, ka1, va, 0);
    __syncthreads();
    mwc = mwn;
  }
#undef ALOAD
#undef AWRITE
  float lsum = 0.f;
#pragma unroll
  for (int r = 0; r < 16; ++r) lsum += lsumv[r];
  lsum += shx(lsum, 32);
  const float inv = 1.f / lsum;
  {
    float* slab = (float*)(smem + 45056 + w * 8704);
#pragma unroll
    for (int j = 0; j < 2; ++j)
#pragma unroll
      for (int g4 = 0; g4 < 4; ++g4)
        *(float4*)(slab + lr * 68 + 32 * j + 8 * g4 + 4 * lh) =
            make_float4(O[j][4 * g4] * inv, O[j][4 * g4 + 1] * inv, O[j][4 * g4 + 2] * inv, O[j][4 * g4 + 3] * inv);
    __builtin_amdgcn_fence(__ATOMIC_RELEASE, "wavefront");
    __builtin_amdgcn_wave_barrier();
    __builtin_amdgcn_fence(__ATOMIC_ACQUIRE, "wavefront");
    const int rr = l >> 3, ch = l & 7;
#pragma unroll
    for (int it = 0; it < 4; ++it) {
      const int row = rr + 8 * it;
      const long o = ((long)(bidx * 2048 + q0 + 32 * w + row)) * 1024 + h * 64 + ch * 8;
      const uint4 z = *(const uint4*)(p.szb() + o);
      const float4 a = *(const float4*)(slab + row * 68 + ch * 8), b = *(const float4*)(slab + row * 68 + ch * 8 + 4);
      uint4 ov;
      ov.x = cvtpk(a.x * bflo(z.x), a.y * bfhi(z.x)); ov.y = cvtpk(a.z * bflo(z.y), a.w * bfhi(z.y));
      ov.z = cvtpk(b.x * bflo(z.z), b.y * bfhi(z.z)); ov.w = cvtpk(b.z * bflo(z.w), b.w * bfhi(z.w));
      st_wt16(p.vb() + o, ov);
    }
  }
}

DI unsigned fkey(float x) {
  if (x == 0.f) x = 0.f;
  const unsigned u = __float_as_uint(x);
  return (u & 0x80000000u) ? ~u : (u | 0x80000000u);
}

template <int R>
DI void idx_select(char* simg, unsigned* mbase, int l, int w) {
  const int j = l & 31, myq = 2 * w + (l >> 5);
  unsigned k2[R];
  {
    const char* src = simg + myq * 8720 + ((R * j) >> 6) * 272 + ((R * j) & 63) * 4;
#pragma unroll
    for (int i = 0; i < R / 4; ++i) { const uint4 v = *(const uint4*)(src + 16 * i); k2[4 * i] = v.x; k2[4 * i + 1] = v.y; k2[4 * i + 2] = v.z; k2[4 * i + 3] = v.w; }
  }
  __syncthreads();
#define DPPU(v, ctl) ((unsigned)__builtin_amdgcn_update_dpp(0, (int)(v), ctl, 0xF, 0xF, true))
#define HALF_SUM(v) { v += DPPU(v, 0xB1); v += DPPU(v, 0x4E); v += DPPU(v, 0x124); v += DPPU(v, 0x128); v += shxu(v, 16); }
  unsigned tq = 0u;
  bool done = false;
  for (int bit = 31; bit >= 0; --bit) {
    const unsigned cand = tq | (1u << bit);
    unsigned cnt = 0u;
    unsigned cntb = 0u;
#pragma unroll
    for (int e = 0; e < R; e += 2) {
      unsigned long long sp;
      asm volatile("v_cmp_ge_u32_e64 %2, %3, %5\n\tv_cmp_ge_u32_e32 vcc, %4, %5\n\tv_addc_co_u32_e64 %0, %2, 0, %0, %2\n\tv_addc_co_u32_e32 %1, vcc, 0, %1, vcc"
                   : "+v"(cnt), "+v"(cntb), "=&s"(sp) : "v"(k2[e]), "v"(k2[e + 1]), "v"(cand) : "vcc");
    }
    cnt += cntb;
    HALF_SUM(cnt);
    if (!done && cnt >= 256u) { tq = cand; if (cnt == 256u) done = true; }
    if (__all(done ? 1 : 0)) break;
  }
  unsigned thr_gt = tq - 1u;
  int J0 = -1;
  const bool wavetie = !__all(done ? 1 : 0);
  const int laneoff = R * j;
  if (wavetie) {
    unsigned cgt = 0u;
#pragma unroll
    for (int e = 0; e < R; ++e)
      asm volatile("v_cmp_gt_u32_e32 vcc, %1, %2\n\tv_addc_co_u32_e32 %0, vcc, 0, %0, vcc" : "+v"(cgt) : "v"(k2[e]), "v"(tq) : "vcc");
    HALF_SUM(cgt);
    const unsigned need = 256u - cgt;
    const int vbig = (int)0x80000000;
    int J = 0;
    for (int bit = 10; bit >= 0; --bit) {
      const int candJ = J | (1 << bit);
      unsigned c2 = 0u;
#pragma unroll
      for (int e = 0; e < R; ++e) {
        unsigned tmp;
        asm volatile("v_cmp_eq_u32_e32 vcc, %2, %3\n\tv_cndmask_b32_e32 %1, %4, %5, vcc\n\tv_cmp_lt_i32_e32 vcc, %6, %1\n\tv_addc_co_u32_e32 %0, vcc, 0, %0, vcc"
                     : "+v"(c2), "=&v"(tmp) : "v"(k2[e]), "v"(tq), "v"(vbig), "v"(candJ - laneoff), "i"(e) : "vcc");
      }
      HALF_SUM(c2);
      if (c2 < need) J = candJ;
    }
    if (!done) { thr_gt = tq; J0 = J; }
  }
#undef HALF_SUM
#undef DPPU
  const int J0l = J0 - laneoff;
  const int vbig2 = (int)0x80000000;
  const unsigned allones = 0xFFFFFFFFu;
  unsigned wd[R / 32];
#pragma unroll
  for (int wi = 0; wi < R / 32; ++wi) {
    unsigned nb = 0u;
#pragma unroll
    for (int e = 31; e >= 0; --e) {
      unsigned k = k2[32 * wi + e];
      if (wavetie) {
        unsigned tmp;
        asm volatile("v_cmp_eq_u32_e32 vcc, %1, %2\n\tv_cndmask_b32_e32 %0, %3, %4, vcc\n\tv_cmp_le_i32_e32 vcc, %6, %0\n\tv_cndmask_b32_e32 %0, %1, %5, vcc"
                     : "=&v"(tmp) : "v"(k), "v"(tq), "v"(vbig2), "v"(J0l), "v"(allones), "i"(32 * wi + e) : "vcc");
        k = tmp;
      }
      asm volatile("v_cmp_gt_u32_e32 vcc, %1, %2\n\tv_addc_co_u32_e32 %0, vcc, %0, %0, vcc" : "+v"(nb) : "v"(k), "v"(thr_gt) : "vcc");
    }
    wd[wi] = nb;
  }
  if (R == 64) *(uint2*)(mbase + myq * 64 + 2 * j) = make_uint2(wd[0], wd[R / 32 - 1]);
  else { mbase[myq * 64 + j] = wd[0]; mbase[myq * 64 + 32 + j] = 0u; }
}

DI void idx_item(const Params& p, char* smem, int bidx, int c, int qq) {
  const int t = otid(), l = t & 63, w = t >> 6, lq = l & 15, lg = l >> 4;
  const int q0 = c * 64 + qq * 16;
  unsigned* mbase = p.mask() + ((long)(bidx * 2048 + q0)) * 64;
  if (c <= 3) {
#pragma unroll
    for (int i = 0; i < 2; ++i) {
      const int idx = t + 512 * i, q = idx >> 6, wd = idx & 63;
      mbase[q * 64 + wd] = (wd < 2 * (c + 1)) ? 0xFFFFFFFFu : 0u;
    }
    return;
  }
  const int ngroups = 2 * (c + 1);
  const int ng = (ngroups - w + 7) >> 3;
  float wv[8];
  {
    const float* wp = p.wif() + (long)(bidx * 2048 + q0 + lq) * 8;
    const float4 a = *(const float4*)wp, b = *(const float4*)(wp + 4);
    wv[0] = a.x; wv[1] = a.y; wv[2] = a.z; wv[3] = a.w; wv[4] = b.x; wv[5] = b.y; wv[6] = b.z; wv[7] = b.w;
  }
  unsigned kx[8][2][4];
  const u16* kp = p.kib() + ((long)(bidx * 2048) + lq) * 64 + 8 * lg;
  bf16x8 af[8][2][2];
#pragma unroll
  for (int gi = 0; gi < 8; ++gi)
#pragma unroll
    for (int sub = 0; sub < 2; ++sub) {
      const int key0 = (w + 8 * gi) * 32 + sub * 16;
      af[gi][sub][0] = *(const bf16x8*)(kp + (long)key0 * 64);
      af[gi][sub][1] = *(const bf16x8*)(kp + (long)key0 * 64 + 32);
    }
  bf16x8* qfl = (bf16x8*)(smem + 2048);
  {
    const u16* qp = p.qib() + ((long)(bidx * 2048 + q0 + lq) * 8) * 64 + 8 * lg;
#pragma unroll
    for (int i = 0; i < 2; ++i) { const int hk = w * 2 + i; qfl[hk * 64 + l] = *(const bf16x8*)(qp + (hk >> 1) * 64 + (hk & 1) * 32); }
  }
  __syncthreads();
  __builtin_amdgcn_sched_barrier(0);
#pragma unroll
  for (int gi = 0; gi < 8; ++gi) {
    if (gi < ng) {
#pragma unroll
      for (int sub = 0; sub < 2; ++sub) {
        int qo = l;
        asm volatile("" : "+v"(qo));
        f32x4 sc = {0.f, 0.f, 0.f, 0.f};
#pragma unroll
        for (int h = 0; h < 8; ++h) {
          f32x4 acc = {0.f, 0.f, 0.f, 0.f};
          acc = mfma16(af[gi][sub][0], qfl[(2 * h) * 64 + qo], acc);
          acc = mfma16(af[gi][sub][1], qfl[(2 * h + 1) * 64 + qo], acc);
#pragma unroll
          for (int r = 0; r < 4; ++r) sc[r] += wv[h] * fmaxf(acc[r], 0.f);
        }
#pragma unroll
        for (int r = 0; r < 4; ++r) kx[gi][sub][r] = fkey(sc[r]);
      }
    } else {
#pragma unroll
      for (int sub = 0; sub < 2; ++sub)
#pragma unroll
        for (int r = 0; r < 4; ++r) kx[gi][sub][r] = 0u;
    }
  }
  char* simg = smem + 18432;
#pragma unroll
  for (int gi = 0; gi < 8; ++gi)
#pragma unroll
    for (int sub = 0; sub < 2; ++sub) {
      const int key0 = (w + 8 * gi) * 32 + sub * 16 + 4 * lg;
      *(uint4*)(simg + lq * 8720 + (key0 >> 6) * 272 + (key0 & 63) * 4) = make_uint4(kx[gi][sub][0], kx[gi][sub][1], kx[gi][sub][2], kx[gi][sub][3]);
    }
  __syncthreads();
  if (c <= 15) idx_select<32>(simg, mbase, l, w);
  else idx_select<64>(simg, mbase, l, w);
}

#define XB_TMO      128
#define XB_XCNT(j)  (256  + 64 * (j))
#define XB_XSUB(j)  (1280 + 64 * (j))
#define XB_XGEN(j)  (2304 + 64 * (j))
#define XB_TOP      3328
#define XB_TOPGEN   3392
#define XCD_BAR_WORDS 3456
#define XB_SPIN_CAP (1u << 20)
#define LAS __attribute__((address_space(3)))
DI unsigned xb_ld(unsigned* p) { return __hip_atomic_load(p, __ATOMIC_RELAXED, __HIP_MEMORY_SCOPE_AGENT); }
DI unsigned xb_add(unsigned* p, unsigned v) { return __hip_atomic_fetch_add(p, v, __ATOMIC_RELAXED, __HIP_MEMORY_SCOPE_AGENT); }
DI unsigned xb_xcc_id() { return (unsigned)__builtin_amdgcn_s_getreg((3 << 11) | 20) & 0xFu; }
#define XB_SPIN(cond, bar) do { unsigned _sp = 0; while (cond) { __builtin_amdgcn_s_sleep(1); \
    if ((++_sp & 255u) == 0u) { if (xb_ld(&(bar)[XB_TMO])) break; if (_sp > XB_SPIN_CAP) { atomicAdd(&(bar)[XB_TMO], 1u); break; } } } } while (0)
struct XcdBarrier { unsigned* bar; unsigned x; volatile LAS unsigned* st; };
DI XcdBarrier xcd_barrier_post(unsigned* bar, volatile LAS unsigned* st) {
  XcdBarrier b; b.bar = bar; b.x = xb_xcc_id(); b.st = st;
  if (threadIdx.x == 0) (void)xb_add(&bar[XB_XCNT(b.x)], 1u);
  return b;
}
DI void xcd_barrier_complete(unsigned* bar, unsigned x, unsigned& nloc, unsigned& nx) {
  const unsigned G = gridDim.x * gridDim.y * gridDim.z;
  unsigned sum, cnt, mine, sp = 0u;
  for (;;) {
    sum = 0u; cnt = 0u; mine = 0u;
#pragma unroll
    for (unsigned j = 0; j < 16; ++j) { const unsigned c = xb_ld(&bar[XB_XCNT(j)]); sum += c; cnt += (c > 0u) ? 1u : 0u; mine = (j == x) ? c : mine; }
    if (sum == G) break;
    __builtin_amdgcn_s_sleep(1);
    if ((++sp & 255u) == 0u) { if (xb_ld(&bar[XB_TMO])) break; if (sp > XB_SPIN_CAP) { atomicAdd(&bar[XB_TMO], 1u); break; } }
  }
  nloc = mine > 0u ? mine : 1u; nx = cnt > 0u ? cnt : 1u;
}
DI void xcd_barrier(const XcdBarrier& b) {
  asm volatile("s_waitcnt vmcnt(0)" ::: "memory");
  __syncthreads();
  if (threadIdx.x == 0) {
    unsigned* bar = b.bar;
    __builtin_amdgcn_s_waitcnt(0);
    unsigned nloc = b.st[0], nx = b.st[1];
    if (nloc == 0u) { xcd_barrier_complete(bar, b.x, nloc, nx); b.st[0] = nloc; b.st[1] = nx; }
    const unsigned old = xb_add(&bar[XB_XSUB(b.x)], 1u);
    const unsigned gen = old / nloc;
    if (old + 1u == (gen + 1u) * nloc) {
      __builtin_amdgcn_fence(__ATOMIC_RELEASE, "agent");
      asm volatile("s_waitcnt vmcnt(0)" ::: "memory");
      const unsigned og = xb_add(&bar[XB_TOP], 1u);
      const unsigned tg = og / nx;
      if (og + 1u == (tg + 1u) * nx) xb_add(&bar[XB_TOPGEN], 1u);
      else XB_SPIN(xb_ld(&bar[XB_TOPGEN]) == tg, bar);
      __builtin_amdgcn_fence(__ATOMIC_ACQUIRE, "agent");
      asm volatile("s_waitcnt vmcnt(0)" ::: "memory");
    } else {
      XB_SPIN(xb_ld(&bar[XB_TOPGEN]) == gen, bar);
      __builtin_amdgcn_fence(__ATOMIC_ACQUIRE, "agent");
      asm volatile("s_waitcnt vmcnt(0)" ::: "memory");
    }
  }
  __syncthreads();
}

DI int fetch_item(const Params& p, char* smem, int which) {
  int* si = (int*)(smem + LDS_ITEM);
  __syncthreads();
  if (threadIdx.x == 0) *si = (int)atomicAdd(&p.counters()[which], 1u);
  __syncthreads();
  return *si;
}

DI void tile_pm_pn(int id, int nM, int nN, int& pm, int& pn) {
  const int nig = 8 * nN, gid = id / nig, fm = gid * 8, gsz = min(nM - fm, 8);
  const int r = id - gid * nig;
  pm = fm + (r % gsz); pn = r / gsz;
}
DI int tile_of(int round, int ntiles) {
  const int b = blockIdx.x, g = gridDim.x;
  const int v = (g % 8 == 0) ? (b & 7) * (g >> 3) + (b >> 3) : b;
  return round * g + v;
}

DI void fill_rs(char* smem, const float* rss, int row0, int rlo, int rhi, float invK) {
  float* rs = (float*)(smem + LDS_RS2);
  const int t = otid();
  if (t < 256) rs[t] = rsqrtf(rss[row0 + t] * invK + EPS_);
}

DI void phase_conv_in(const Params& p, char* smem, int layer) {
  const u16* Wt = layer ? p.WaT1() : p.WaT0();
  const float* rss = p.rss() + (layer ? 3 : 0) * 16384;
  const float* rs0_ = (const float*)(smem + LDS_RS2);
  for (int round = 0; round * (int)gridDim.x < 64 * 16; ++round) {
    const int tile = tile_of(round, 64 * 16);
    if (tile < 64 * 16) {
      int pm, pn; tile_pm_pn(tile, 64, 16, pm, pn);
      acc_t acc;
      gemm256(p.xb(), (long)pm * 256, (long)pm * 256 + 128, Wt, pn * 256, 1024, smem, acc);
      fill_rs(smem, rss, pm * 256, 0, 16384, 1.f / 1024.f);
#pragma unroll
      for (int ai = 0; ai < 2; ++ai) {
        dump_half(acc, ai, smem);
        int tx_ = threadIdx.x; asm volatile("" : "+v"(tx_));
        const int tq = tx_ & 255, hq = tx_ >> 8;
        const float* rs = rs0_ + ai * 128;
        __syncthreads();
        epi_conv(p, smem + hq * LDS_Q, rs, tq, layer, pm * 256 + ai * 128, ai, pm, pn * 2 + hq, (float*)(smem + LDS_UPREV) + hq * 64);
        __syncthreads();
      }
    }
  }
}

DI void phase_out(const Params& p, char* smem, const u16* Wt, float* rss_next, const float* res_in, int conv_layer) {
  const float* rs0_ = (const float*)(smem + LDS_RS2);
  for (int round = 0; round * (int)gridDim.x < 64 * 4; ++round) {
    const int tile = tile_of(round, 64 * 4);
    if (tile < 64 * 4) {
      int pm, pn; tile_pm_pn(tile, 64, 4, pm, pn);
      acc_t acc;
      if (conv_layer >= 0) conv_fixup(p, conv_layer, pm);
      gemm256(p.vb(), (long)pm * 256, (long)pm * 256 + 128, Wt, pn * 256, 1024, smem, acc);
#pragma unroll
      for (int ai = 0; ai < 2; ++ai) {
        dump_half(acc, ai, smem);
        int tx_ = threadIdx.x; asm volatile("" : "+v"(tx_));
        const int tq = tx_ & 255, hq = tx_ >> 8;
        const float* rs = rs0_;
        __syncthreads();
        epi_res(p, smem + hq * LDS_Q, rs, tq, pm * 256 + ai * 128, pn * 256 + hq * 128, rss_next, res_in);
        __syncthreads();
      }
    }
  }
}

DI void phase_bin(const Params& p, char* smem) {
  const float* rs0_ = (const float*)(smem + LDS_RS2);
  for (int round = 0; round * (int)gridDim.x < 64 * 19; ++round) {
    const int tile = tile_of(round, 64 * 19);
    if (tile < 64 * 19) {
      int pm, pn; tile_pm_pn(tile, 64, 19, pm, pn);
      acc_t acc;
      gemm256(p.xb(), (long)pm * 256, (long)pm * 256 + 128, p.WbT(), pn * 256, 1024, smem, acc);
      fill_rs(smem, p.rss() + 16384, pm * 256, 0, 16384, 1.f / 1024.f);
#pragma unroll
      for (int ai = 0; ai < 2; ++ai) {
        dump_half(acc, ai, smem);
        int tx_ = threadIdx.x; asm volatile("" : "+v"(tx_));
        const int tq = tx_ & 255, hq = tx_ >> 8;
        const float* rs = rs0_ + ai * 128;
        __syncthreads();
        VReg vr;
#pragma unroll
        for (int i_ = 0; i_ < 8; ++i_) vr.v[i_] = make_uint4(0u, 0u, 0u, 0u);
        epi_bin(p, smem + hq * LDS_Q, rs, tq, pm * 256 + ai * 128, pn * 2 + hq, vr);
        __syncthreads();
        copy_bin(p, smem + hq * LDS_Q, tq, pm * 256 + ai * 128, pn * 2 + hq, vr);
        __syncthreads();
        copy2_bin(p, smem + hq * LDS_Q, tq, pm * 256 + ai * 128, pn * 2 + hq);
        __syncthreads();
      }
    }
  }
}

DI void phase_cin(const Params& p, char* smem) {
  const float* rs0_ = (const float*)(smem + LDS_RS2);
  for (int round = 0; round * (int)gridDim.x < 64 * 7; ++round) {
    const int tile = tile_of(round, 64 * 7);
    if (tile < 64 * 7) {
      int pm, pn; tile_pm_pn(tile, 64, 7, pm, pn);
      acc_t acc;
      gemm256(p.xb(), (long)pm * 256, (long)pm * 256 + 128, p.WcT(), pn * 256, 1024, smem, acc);
      fill_rs(smem, p.rss() + 2 * 16384, pm * 256, 0, 16384, 1.f / 1024.f);
#pragma unroll
      for (int ai = 0; ai < 2; ++ai) {
        dump_half(acc, ai, smem);
        int tx_ = threadIdx.x; asm volatile("" : "+v"(tx_));
        const int tq = tx_ & 255, hq = tx_ >> 8;
        const float* rs = rs0_ + ai * 128;
        __syncthreads();
        epi_cin(p, smem + hq * LDS_Q, rs, tq, pm * 256 + ai * 128, pn * 2 + hq);
        __syncthreads();
      }
    }
  }
}

DI void phase_up(const Params& p, char* smem) {
  const float* rs0_ = (const float*)(smem + LDS_RS2);
  for (int round = 0; round * (int)gridDim.x < 1024; ++round) {
    const int tile = tile_of(round, 1024);
    if (tile < 1024) {
      const int which = tile >> 9;
      int pm, pn; tile_pm_pn(tile & 511, 64, 8, pm, pn);
      acc_t acc;
      if (which == 0) gemm256(p.cqb(), (long)pm * 256, (long)pm * 256 + 128, p.WuqT(), pn * 256, 384, smem, acc);
      else gemm256(p.ckvb(), (long)pm * 256, (long)pm * 256 + 128, p.WukvT(), pn * 256, 256, smem, acc);
      if (which == 0) fill_rs(smem, p.rss() + 4 * 16384, pm * 256, 0, 16384, 1.f / 384.f);
      else fill_rs(smem, p.rss() + 5 * 16384, pm * 256, 0, 16384, 1.f / 256.f);
#pragma unroll
      for (int ai = 0; ai < 2; ++ai) {
        dump_half(acc, ai, smem);
        int tx_ = threadIdx.x; asm volatile("" : "+v"(tx_));
        const int tq = tx_ & 255, hq = tx_ >> 8;
        const float* rs = rs0_ + ai * 128;
        __syncthreads();
        VReg vr;
#pragma unroll
        for (int i_ = 0; i_ < 8; ++i_) vr.v[i_] = make_uint4(0u, 0u, 0u, 0u);
        if (which == 0) epi_uq(p, smem + hq * LDS_Q, rs, tq, pm * 256 + ai * 128, pn * 2 + hq);
        else epi_ukv(p, smem + hq * LDS_Q, rs, tq, pm * 256 + ai * 128, pn * 2 + hq, vr);
        __syncthreads();
        if (which == 0) copy_uq(p, smem + hq * LDS_Q, tq, pm * 256 + ai * 128, pn * 2 + hq);
        else copy_ukv(p, smem + hq * LDS_Q, tq, pm * 256 + ai * 128, pn * 2 + hq, vr);
        __syncthreads();
        if (which != 0) copy2_ukv(p, smem + hq * LDS_Q, tq, pm * 256 + ai * 128, pn * 2 + hq);
        __syncthreads();
      }
    }
  }
}

DI void phase_idx(const Params& p, char* smem, int counter) {
  int* si = (int*)(smem + LDS_ITEM);
  int it = blockIdx.x;
  __syncthreads();
  while (it < 1024) {
    unsigned nxt = 0u;
    if (threadIdx.x == 0) nxt = atomicAdd(&p.counters()[counter], 1u) + gridDim.x;
    const int c = 31 - (it >> 5), r = it & 31;
    idx_item(p, smem, r >> 2, c, r & 3);
    __syncthreads();
    if (threadIdx.x == 0) *si = (int)nxt;
    __syncthreads();
    it = *si;
  }
}

template <int DQK, bool MASKED>
DI void phase_attn(const Params& p, char* smem, int counter) {
  int* si = (int*)(smem + LDS_ITEM);
  int it = blockIdx.x;
  __syncthreads();
  while (it < 1024) {
    unsigned nxt = 0u;
    if (threadIdx.x == 0) nxt = atomicAdd(&p.counters()[counter], 1u) + gridDim.x;
    const int qt = 7 - (it >> 7), bh = it & 127;
    const u16* vTb = MASKED ? vT1_ptr(p, bh) : ((const u16*)p.out + (long)bh * 131072);
    attn_item<DQK, MASKED>(p, smem, bh >> 4, bh & 15, qt, vTb);
    __syncthreads();
    if (threadIdx.x == 0) *si = (int)nxt;
    __syncthreads();
    it = *si;
  }
}

__global__ void __launch_bounds__(512, 2) mega_kernel(Params p, int ph_lo, int ph_hi) {
  __shared__ __attribute__((aligned(16))) char smem[LDS_TOTAL];
  cg::grid_group grid = cg::this_grid();
  __shared__ uint4 xb_words;
  if (threadIdx.x == 0) xb_words = make_uint4(0u, 0u, 0u, 0u);
  __syncthreads();
  const XcdBarrier xbar = xcd_barrier_post(p.bar(), (volatile LAS unsigned*)&xb_words);
  if (ph_hi > 1000) grid.sync();
#ifndef ONLYP
#define ONLYP -1
#endif
#define PHON(n) (ONLYP < 0 || ONLYP == (n))
#ifndef REPMASK
#define REPMASK 0
#endif
#define RUNPH(n, gate, call)                                                  \
  if (ph_lo <= (n) && (n) < ph_hi) {                                          \
    for (int rep = 0; rep < 1 + ((REPMASK >> (n)) & 1); ++rep) {              \
      if (PHON(gate)) { call; }                                               \
      if ((n) + 1 < ph_hi) xcd_barrier(xbar);                                 \
    }                                                                         \
  }
  RUNPH(0, 0, phase_prep(p, smem))
  RUNPH(1, 1, phase_conv_in(p, smem, 0))
  RUNPH(2, 2, phase_out(p, smem, p.WaoT0(), p.rss() + 16384, p.x, 0))
  RUNPH(3, 3, phase_bin(p, smem))
  RUNPH(4, 4, phase_idx(p, smem, 0 + 4 * rep))
  RUNPH(5, 5, (phase_attn<64, true>(p, smem, 1 + 4 * rep)))
  RUNPH(6, 2, phase_out(p, smem, p.WboT(), p.rss() + 2 * 16384, p.out, -1))
  RUNPH(7, 7, phase_cin(p, smem))
  RUNPH(8, 8, phase_up(p, smem))
  RUNPH(9, 9, (phase_attn<96, false>(p, smem, 2 + 4 * rep)))
  RUNPH(10, 2, phase_out(p, smem, p.WcoT(), p.rss() + 3 * 16384, p.out, -1))
  RUNPH(11, 1, phase_conv_in(p, smem, 1))
  RUNPH(12, 2, phase_out(p, smem, p.WaoT1(), nullptr, nullptr, 1))
}

extern "C" void kernel_launch(void* const* d_in, const int* in_sizes, int n_in, void* d_out, int out_size, void* d_ws,
                              size_t ws_size, hipStream_t stream) {
  static int grid_blocks = 0;
  if (!grid_blocks) {
    int dev = 0, cus = 0, per_cu = 0;
    hipGetDevice(&dev);
    hipDeviceGetAttribute(&cus, hipDeviceAttributeMultiprocessorCount, dev);
    hipOccupancyMaxActiveBlocksPerMultiprocessor(&per_cu, mega_kernel, 512, 0);
    if (per_cu > 1) per_cu = 1;
    if (per_cu < 1) per_cu = 1;
    grid_blocks = cus * per_cu;
  }
  const size_t need = 265703424ull;
  if (ws_size < need) { fprintf(stderr, "workspace too small: %zu < %zu\n", ws_size, need); return; }
  Params p{};
  p.x = (const float*)d_in[0]; p.pos = (const int*)d_in[1];
  p.a_norm = (const float*)d_in[2]; p.a_w_in = (const float*)d_in[3]; p.a_conv_w = (const float*)d_in[4];
  p.a_conv_b = (const float*)d_in[5]; p.a_w_out = (const float*)d_in[6];
  p.b_norm = (const float*)d_in[7]; p.b_w_in = (const float*)d_in[8]; p.b_q_norm = (const float*)d_in[9];
  p.b_k_norm = (const float*)d_in[10]; p.b_w_out = (const float*)d_in[11];
  p.c_norm = (const float*)d_in[12]; p.c_w_in = (const float*)d_in[13]; p.c_q_lat_norm = (const float*)d_in[14];
  p.c_kv_lat_norm = (const float*)d_in[15]; p.c_w_uq = (const float*)d_in[16]; p.c_w_ukv = (const float*)d_in[17];
  p.c_q_norm = (const float*)d_in[18]; p.c_k_norm = (const float*)d_in[19]; p.c_w_out = (const float*)d_in[20];
  p.out = (float*)d_out;
  p.ws = (char*)d_ws;
  hipMemsetAsync(p.ws + 263716864, 0, 4096 + 16384, stream);
  int lo = 0, hi = 13;
  void* args[] = {&p, &lo, &hi};
  hipError_t e = hipLaunchCooperativeKernel((void*)mega_kernel, dim3(grid_blocks), dim3(512), args, 0, stream);
  if (e != hipSuccess) fprintf(stderr, "cooperative launch failed: %s (grid %d)\n", hipGetErrorString(e), grid_blocks);
}
```
